# Optimizing an MI355X kernel written in HIP

```python
import jax
import jax.numpy as jnp
from jax import lax
import numpy as np

D_MODEL = 1024
BATCH = 8
SEQ = 4096
DEPTH = 1

GRID_W = 64
CTX_LEN = 256
N_HEADS = 8
N_KV_HEADS = 2
Q_PER_KV = N_HEADS // N_KV_HEADS
HEAD_DIM = 64
ATTN_WIDTH = N_HEADS * HEAD_DIM
KV_WIDTH = N_KV_HEADS * HEAD_DIM
WINDOW = 128
ATTN_BLOCK = 128
SGU_HEADS = 8
SGU_HEAD_DIM = 64
SGU_WIDTH = SGU_HEADS * SGU_HEAD_DIM
SGU_CHUNK = 128
MIX_WIDTH = ATTN_WIDTH + SGU_WIDTH
KV_START = ATTN_WIDTH
KV_END = ATTN_WIDTH + 2 * KV_WIDTH
IN_WIDTH = KV_END + 2 * SGU_WIDTH
N_EXPERTS = 32
TOP_K = 4
D_FF_EXPERT = 1024
SWIGLU_LIMIT = 7.0
SWIGLU_ALPHA = 1.702
MOE_BLOCK = 256
ROPE_THETA = 10000.0
EPS = 1e-6
N_MOD = 6

kernel_name = "hybrid_swa_sgu_moe_dit_block"


def rms_norm(x, g):
    xf = x.astype(jnp.float32)
    y = xf * lax.rsqrt(jnp.mean(xf * xf, axis=-1, keepdims=True) + EPS)
    return (y * g.astype(jnp.float32)).astype(x.dtype)


def layer_norm(x, g, b):
    xf = x.astype(jnp.float32)
    mu = jnp.mean(xf, axis=-1, keepdims=True)
    var = jnp.mean(jnp.square(xf - mu), axis=-1, keepdims=True)
    y = (xf - mu) * lax.rsqrt(var + EPS) * g.astype(jnp.float32) + b.astype(jnp.float32)
    return y.astype(x.dtype)


def modulate(x, shift, scale):
    return x * (1 + scale) + shift


def axial_rope_tables(n_tokens, dtype):
    rows = n_tokens // GRID_W
    pos_row = jnp.repeat(jnp.arange(rows, dtype=jnp.float32), GRID_W)
    pos_col = jnp.tile(jnp.arange(GRID_W, dtype=jnp.float32), rows)
    n_freq = HEAD_DIM // 4
    inv_freq = ROPE_THETA ** (-jnp.arange(n_freq, dtype=jnp.float32) / n_freq)
    ang_r = pos_row[:, None, None] * inv_freq
    ang_c = pos_col[:, None, None] * inv_freq
    return (jnp.cos(ang_r).astype(dtype), jnp.sin(ang_r).astype(dtype),
            jnp.cos(ang_c).astype(dtype), jnp.sin(ang_c).astype(dtype))


def rope_axis(x, cos, sin):
    x1, x2 = jnp.split(x, 2, axis=-1)
    return jnp.concatenate([x1 * cos - x2 * sin, x2 * cos + x1 * sin], axis=-1)


def apply_axial_rope(x, tables):
    cos_r, sin_r, cos_c, sin_c = tables
    half = HEAD_DIM // 2
    return jnp.concatenate([rope_axis(x[..., :half], cos_r, sin_r),
                            rope_axis(x[..., half:], cos_c, sin_c)], axis=-1)


def split_projection(p):
    return jnp.split(p, [ATTN_WIDTH, ATTN_WIDTH + KV_WIDTH, KV_END, KV_END + SGU_WIDTH], axis=-1)


def window_attention(q, k, v, k_ctx, v_ctx, sink):
    B, S = q.shape[0], q.shape[1]
    L = k_ctx.shape[1]
    nb = S // ATTN_BLOCK
    scale = HEAD_DIM ** -0.5
    qb = q.reshape(B, nb, ATTN_BLOCK, N_KV_HEADS, Q_PER_KV, HEAD_DIM)

    def band(t):
        tp = jnp.pad(t, ((0, 0), (ATTN_BLOCK, ATTN_BLOCK), (0, 0), (0, 0)))
        tp = tp.reshape(B, nb + 2, ATTN_BLOCK, N_KV_HEADS, HEAD_DIM)
        return jnp.concatenate([tp[:, :-2], tp[:, 1:-1], tp[:, 2:]], axis=2)

    kb, vb = band(k), band(v)
    s_loc = jnp.einsum('bnqkgd,bnjkd->bnkgqj', qb, kb).astype(jnp.float32) * scale
    qi = jnp.arange(ATTN_BLOCK)[:, None]
    kj = jnp.arange(3 * ATTN_BLOCK)[None, :] - ATTN_BLOCK
    key_pos = jnp.arange(nb)[:, None, None] * ATTN_BLOCK + kj[None]
    valid = (jnp.abs(kj - qi) <= WINDOW)[None] & (key_pos >= 0) & (key_pos < S)
    s_loc = jnp.where(valid[None, :, None, None], s_loc, -jnp.inf)
    s_ctx = jnp.einsum('bnqkgd,bjkd->bnkgqj', qb, k_ctx).astype(jnp.float32) * scale
    s_sink = jnp.broadcast_to(sink.astype(jnp.float32).reshape(N_KV_HEADS, Q_PER_KV, 1, 1),
                              s_loc.shape[:-1] + (1,))
    p = jax.nn.softmax(jnp.concatenate([s_loc, s_ctx, s_sink], axis=-1), axis=-1)
    n_loc = 3 * ATTN_BLOCK
    p_loc = p[..., :n_loc].astype(v.dtype)
    p_ctx = p[..., n_loc:n_loc + L].astype(v.dtype)
    o = (jnp.einsum('bnkgqj,bnjkd->bnqkgd', p_loc, vb)
         + jnp.einsum('bnkgqj,bjkd->bnqkgd', p_ctx, v_ctx))
    return o.reshape(B, S, ATTN_WIDTH)


def context_attention(q, k, v, sink):
    B, L = q.shape[0], q.shape[1]
    qg = q.reshape(B, L, N_KV_HEADS, Q_PER_KV, HEAD_DIM)
    s = jnp.einsum('bqkgd,bjkd->bkgqj', qg, k).astype(jnp.float32) * (HEAD_DIM ** -0.5)
    s_sink = jnp.broadcast_to(sink.astype(jnp.float32).reshape(N_KV_HEADS, Q_PER_KV, 1, 1),
                              s.shape[:-1] + (1,))
    p = jax.nn.softmax(jnp.concatenate([s, s_sink], axis=-1), axis=-1)
    o = jnp.einsum('bkgqj,bjkd->bqkgd', p[..., :L].astype(v.dtype), v)
    return o.reshape(B, L, ATTN_WIDTH)


def spatial_gating(u, v, ln_g, ln_b, w_s, b_s):
    B, N = u.shape[0], u.shape[1]
    nc = N // SGU_CHUNK
    u = jax.nn.gelu(u)
    v = layer_norm(jax.nn.gelu(v), ln_g, ln_b)
    vc = v.reshape(B, nc, SGU_CHUNK, SGU_HEADS, SGU_HEAD_DIM)
    mixed = jnp.einsum('hij,bnjhc->bnihc', w_s, vc) + b_s.T[None, None, :, :, None]
    return u * mixed.reshape(B, N, SGU_WIDTH)


def merge_heads(attn_o, sgu_o, g_attn_out, g_sgu_out, w_out, b_out):
    o = jnp.concatenate([rms_norm(attn_o, g_attn_out), rms_norm(sgu_o, g_sgu_out)], axis=-1)
    return o @ w_out + b_out


def moe_ffn(h, w_router, b_router, w_gate_up, b_gate_up, w_down, b_down):
    shape = h.shape
    xt = h.reshape(-1, D_MODEL)
    T = xt.shape[0]
    logits = (xt @ w_router + b_router).astype(jnp.float32)
    top_logits, top_idx = lax.top_k(logits, TOP_K)
    gates = jax.nn.softmax(top_logits, axis=-1)
    M = T * TOP_K
    expert_flat = top_idx.reshape(-1)
    order = jnp.argsort(expert_flat)
    e_sorted = expert_flat[order]
    tok_sorted = order // TOP_K
    gate_sorted = gates.reshape(-1)[order]
    counts = jnp.zeros((N_EXPERTS,), jnp.int32).at[expert_flat].add(1)
    start = jnp.cumsum(counts) - counts
    padded = (counts + MOE_BLOCK - 1) // MOE_BLOCK * MOE_BLOCK
    pad_end = jnp.cumsum(padded)
    pad_start = pad_end - padded
    dest = pad_start[e_sorted] + jnp.arange(M) - start[e_sorted]
    n_blocks = -(-M // MOE_BLOCK) + N_EXPERTS
    P = n_blocks * MOE_BLOCK
    row_tok = jnp.full((P,), T, jnp.int32).at[dest].set(tok_sorted.astype(jnp.int32))
    row_gate = jnp.zeros((P,), jnp.float32).at[dest].set(gate_sorted)
    block_start = jnp.arange(n_blocks) * MOE_BLOCK
    block_expert = jnp.minimum(jnp.sum(pad_end[None, :] <= block_start[:, None], axis=1), N_EXPERTS - 1)
    x_pad = jnp.concatenate([xt, jnp.zeros((1, D_MODEL), xt.dtype)], axis=0)

    def expert_block(args):
        rows, e = args
        xb = x_pad[rows]
        gu = xb @ w_gate_up[e] + b_gate_up[e]
        gate, up = jnp.split(gu, 2, axis=-1)
        gate = jnp.minimum(gate, SWIGLU_LIMIT)
        up = jnp.clip(up, -SWIGLU_LIMIT, SWIGLU_LIMIT)
        act = (up + 1) * gate * jax.nn.sigmoid(SWIGLU_ALPHA * gate)
        return act @ w_down[e] + b_down[e]

    y_rows = lax.map(expert_block, (row_tok.reshape(n_blocks, MOE_BLOCK), block_expert))
    y_rows = y_rows.reshape(P, D_MODEL) * row_gate[:, None].astype(y_rows.dtype)
    y = jax.ops.segment_sum(y_rows, row_tok, num_segments=T + 1)[:T]
    return y.reshape(shape)


def setup_inputs(seed: int = 0) -> dict:
    key = jax.random.key(seed)
    ks = jax.random.split(key, 27)
    f32 = jnp.float32

    def nrm(k, shape, scale):
        return jax.random.normal(k, shape, f32) * scale

    def gain(k, shape):
        return 1.0 + 0.02 * jax.random.normal(k, shape, f32)

    L = DEPTH
    return {
        "x": nrm(ks[0], (BATCH, SEQ, D_MODEL), 1.0),
        "c": nrm(ks[1], (BATCH, D_MODEL), 1.0),
        "ctx": nrm(ks[2], (BATCH, CTX_LEN, D_MODEL), 1.0),
        "c_ctx": nrm(ks[3], (D_MODEL,), 1.0),
        "w_ada": nrm(ks[4], (L, D_MODEL, N_MOD * D_MODEL), 0.5 * D_MODEL ** -0.5),
        "b_ada": nrm(ks[5], (L, N_MOD * D_MODEL), 0.02),
        "g_pre_mix": gain(ks[6], (L, D_MODEL)),
        "g_post_mix": gain(ks[7], (L, D_MODEL)),
        "g_pre_ffn": gain(ks[8], (L, D_MODEL)),
        "g_post_ffn": gain(ks[9], (L, D_MODEL)),
        "w_in": nrm(ks[10], (L, D_MODEL, IN_WIDTH), D_MODEL ** -0.5),
        "b_in": nrm(ks[11], (L, IN_WIDTH), 0.02),
        "attn_sink": nrm(ks[12], (L, N_HEADS), 0.5),
        "sgu_ln_g": gain(ks[13], (L, SGU_WIDTH)),
        "sgu_ln_b": nrm(ks[14], (L, SGU_WIDTH), 0.02),
        "sgu_w": nrm(ks[15], (L, SGU_HEADS, SGU_CHUNK, SGU_CHUNK), SGU_CHUNK ** -0.5),
        "sgu_b": gain(ks[16], (L, SGU_HEADS, SGU_CHUNK)),
        "g_attn_out": gain(ks[17], (L, ATTN_WIDTH)),
        "g_sgu_out": gain(ks[18], (L, SGU_WIDTH)),
        "w_out": nrm(ks[19], (L, MIX_WIDTH, D_MODEL), MIX_WIDTH ** -0.5),
        "b_out": nrm(ks[20], (L, D_MODEL), 0.02),
        "w_router": nrm(ks[21], (L, D_MODEL, N_EXPERTS), D_MODEL ** -0.5),
        "b_router": nrm(ks[22], (L, N_EXPERTS), 0.01),
        "w_gate_up": nrm(ks[23], (L, N_EXPERTS, D_MODEL, 2 * D_FF_EXPERT), D_MODEL ** -0.5),
        "b_gate_up": nrm(ks[24], (L, N_EXPERTS, 2 * D_FF_EXPERT), 0.02),
        "w_down": nrm(ks[25], (L, N_EXPERTS, D_FF_EXPERT, D_MODEL), D_FF_EXPERT ** -0.5),
        "b_down": nrm(ks[26], (L, N_EXPERTS, D_MODEL), 0.02),
    }


def reference(x, c, ctx, c_ctx, w_ada, b_ada, g_pre_mix, g_post_mix, g_pre_ffn, g_post_ffn,
              w_in, b_in, attn_sink, sgu_ln_g, sgu_ln_b, sgu_w, sgu_b, g_attn_out, g_sgu_out,
              w_out, b_out, w_router, b_router, w_gate_up, b_gate_up, w_down, b_down):
    B, S = x.shape[0], x.shape[1]
    Lc = ctx.shape[1]
    rope = axial_rope_tables(S, x.dtype)
    for l in range(DEPTH):
        mod = jax.nn.silu(c) @ w_ada[l] + b_ada[l]
        sh1, sc1, gt1, sh2, sc2, gt2 = jnp.split(mod[:, None, :], N_MOD, axis=-1)
        mod_ctx = jax.nn.silu(c_ctx) @ w_ada[l] + b_ada[l]
        csh1, csc1, cgt1, csh2, csc2, cgt2 = jnp.split(mod_ctx, N_MOD)

        h = modulate(rms_norm(x, g_pre_mix[l]), sh1, sc1)
        q, k, v, su, sv = split_projection(h @ w_in[l] + b_in[l])
        q = apply_axial_rope(q.reshape(B, S, N_HEADS, HEAD_DIM), rope)
        k = apply_axial_rope(k.reshape(B, S, N_KV_HEADS, HEAD_DIM), rope)
        v = v.reshape(B, S, N_KV_HEADS, HEAD_DIM)

        hc = modulate(rms_norm(ctx, g_pre_mix[l]), csh1, csc1)
        if l < DEPTH - 1:
            qc, kc, vc, suc, svc = split_projection(hc @ w_in[l] + b_in[l])
        else:
            kc, vc = jnp.split(hc @ w_in[l][:, KV_START:KV_END] + b_in[l][KV_START:KV_END], 2, axis=-1)
        kc = kc.reshape(B, Lc, N_KV_HEADS, HEAD_DIM)
        vc = vc.reshape(B, Lc, N_KV_HEADS, HEAD_DIM)

        attn_o = window_attention(q, k, v, kc, vc, attn_sink[l])
        sgu_o = spatial_gating(su, sv, sgu_ln_g[l], sgu_ln_b[l], sgu_w[l], sgu_b[l])
        mix = merge_heads(attn_o, sgu_o, g_attn_out[l], g_sgu_out[l], w_out[l], b_out[l])
        x_mid = x + gt1 * rms_norm(mix, g_post_mix[l])

        h2 = modulate(rms_norm(x_mid, g_pre_ffn[l]), sh2, sc2)
        ffn = moe_ffn(h2, w_router[l], b_router[l], w_gate_up[l], b_gate_up[l], w_down[l], b_down[l])
        x_new = x_mid + gt2 * rms_norm(ffn, g_post_ffn[l])

        if l < DEPTH - 1:
            qc = qc.reshape(B, Lc, N_HEADS, HEAD_DIM)
            attn_c = context_attention(qc, kc, vc, attn_sink[l])
            sgu_c = spatial_gating(suc, svc, sgu_ln_g[l], sgu_ln_b[l], sgu_w[l], sgu_b[l])
            mix_c = merge_heads(attn_c, sgu_c, g_attn_out[l], g_sgu_out[l], w_out[l], b_out[l])
            ctx_mid = ctx + cgt1 * rms_norm(mix_c, g_post_mix[l])
            hc2 = modulate(rms_norm(ctx_mid, g_pre_ffn[l]), csh2, csc2)
            ffn_c = moe_ffn(hc2, w_router[l], b_router[l], w_gate_up[l], b_gate_up[l], w_down[l], b_down[l])
            ctx = ctx_mid + cgt2 * rms_norm(ffn_c, g_post_ffn[l])
        x = x_new
    return x
```

```cpp
#include <hip/hip_runtime.h>
#include <cstdio>
#include <cstdint>

#ifndef MK_N_LAUNCHES
#define MK_N_LAUNCHES 1
#endif
#ifndef PROBE
#define PROBE 0
#endif
#ifndef CHECKS
#define CHECKS 0
#endif
#ifndef CHECK_BIT
#define CHECK_BIT 0
#endif
#ifndef NAIVE_ATTN
#define NAIVE_ATTN 0
#endif
#ifndef NAIVE_SGU
#define NAIVE_SGU 0
#endif
#ifndef GEMM_NAIVE
#define GEMM_NAIVE 0
#endif

#define GAS __attribute__((address_space(1)))
#define LAS __attribute__((address_space(3)))
typedef unsigned short bf16;
typedef unsigned v4u __attribute__((ext_vector_type(4)));
typedef unsigned v2u __attribute__((ext_vector_type(2)));
typedef float f32x4 __attribute__((ext_vector_type(4)));
typedef float f32x2 __attribute__((ext_vector_type(2)));
typedef float f32x16 __attribute__((ext_vector_type(16)));
typedef short bf16x8 __attribute__((ext_vector_type(8)));
typedef short s16x4 __attribute__((ext_vector_type(4)));
typedef GAS unsigned gu32;

constexpr int NB = 8, SEQ = 4096, DM = 1024, TT = NB * SEQ;
constexpr int LC = 256, TC = NB * LC;
constexpr int NIN = 1792, NE = 32, FF = 1024, NMOD = 6 * DM;
constexpr int ECAP = 32768;
constexpr int MAXTILES = 544;
constexpr float EPS = 1e-6f;
constexpr float LOG2E = 1.4426950408889634f;
constexpr float QSCALE = 0.125f * LOG2E;

constexpr size_t MiB = 1u << 20;
constexpr size_t WS_CTL = 0, CTL_ZERO_BYTES = 1 * MiB;
constexpr size_t WS_MOD = 1 * MiB;
constexpr size_t WS_ROPE = 1 * MiB + 256 * 1024;
constexpr size_t WS_SGUW = 1 * MiB + 512 * 1024;
constexpr size_t WS_WIN = 2 * MiB;
constexpr size_t WS_WOUT = 6 * MiB;
constexpr size_t WS_WGU = 8 * MiB;
constexpr size_t WS_WD = 136 * MiB;
constexpr size_t WS_GATES = 200 * MiB;
constexpr size_t WS_ROWDST = 201 * MiB;
constexpr size_t WS_H2 = 206 * MiB;
constexpr size_t WS_Y4 = 270 * MiB;
constexpr size_t WS_H = 526 * MiB;
constexpr size_t WS_Q = 594 * MiB;
constexpr size_t WS_K = 626 * MiB;
constexpr size_t WS_V = 634 * MiB;
constexpr size_t WS_KC = 642 * MiB;
constexpr size_t WS_VC = 642 * MiB + 512 * 1024;
constexpr size_t WS_U = 643 * MiB;
constexpr size_t WS_GV = 675 * MiB;
constexpr size_t WS_O = 707 * MiB;
constexpr size_t WS_MIX = 771 * MiB;
constexpr size_t WS_ACT = 526 * MiB;
constexpr size_t WS_END = 835 * MiB;
static_assert(WS_ACT + (size_t)MAXTILES * 256 * FF * 2 <= WS_END, "act overlay");
static_assert(WS_H + (size_t)(TT + TC) * DM * 2 <= WS_Q, "h");

constexpr int CW_TMO = 0;
constexpr int CW_BAR = 4096;
constexpr int CW_CNT = 16384;

constexpr int RING_BYTES = 131072;
constexpr int MISC_OFF = RING_BYTES;
constexpr int LDS_BYTES = 147456;
constexpr int L_BARW = MISC_OFF + 32;
constexpr int L_XCH = MISC_OFF + 1024;
constexpr int L_TILEE = MISC_OFF + 6144;
constexpr int L_CNT = MISC_OFF + 7168;
constexpr int L_SEL = MISC_OFF + 8192;

#define RLX_AGENT __ATOMIC_RELAXED, __HIP_MEMORY_SCOPE_AGENT
#define LDS_WAIT() asm volatile("s_waitcnt lgkmcnt(0)" ::: "memory")
#define VM_WAIT() asm volatile("s_waitcnt vmcnt(0)" ::: "memory")
__device__ __forceinline__ unsigned f2bf(float f) { unsigned u = __builtin_bit_cast(unsigned, f); return (u + 0x7fffu + ((u >> 16) & 1u)) >> 16; }
__device__ __forceinline__ unsigned pk2(float lo, float hi) { return f2bf(lo) | (f2bf(hi) << 16); }
__device__ __forceinline__ unsigned cvt_pk_bf16(float lo, float hi) { unsigned r; asm volatile("v_cvt_pk_bf16_f32 %0, %1, %2" : "=v"(r) : "v"(lo), "v"(hi)); return r; }
__device__ __forceinline__ float bflo(unsigned u) { return __builtin_bit_cast(float, u << 16); }
__device__ __forceinline__ float bfhi(unsigned u) { return __builtin_bit_cast(float, u & 0xffff0000u); }
__device__ __forceinline__ float wave_sum(float v) {
#pragma unroll
    for (int o = 1; o < 64; o <<= 1) v += __shfl_xor(v, o);
    return v;
}
__device__ __forceinline__ float gelu_tanh(float x) {
    const float u = 0.7978845608028654f * (x + 0.044715f * x * x * x);
    return x * __builtin_amdgcn_rcpf(1.0f + __builtin_amdgcn_exp2f(-2.0f * LOG2E * u));
}

#define XB_TMO      128
#define XB_XCNT(j)  (256  + 64 * (j))
#define XB_XSUB(j)  (1280 + 64 * (j))
#define XB_XGEN(j)  (2304 + 64 * (j))
#define XB_TOP      3328
#define XB_TOPGEN   3392
#define XCD_BAR_WORDS 3456
#define XB_SPIN_CAP (1u << 18)
__device__ __forceinline__ unsigned xb_ld(unsigned* p)              { return __hip_atomic_load(p, __ATOMIC_RELAXED, __HIP_MEMORY_SCOPE_AGENT); }
__device__ __forceinline__ unsigned xb_add(unsigned* p, unsigned v) { return __hip_atomic_fetch_add(p, v, __ATOMIC_RELAXED, __HIP_MEMORY_SCOPE_AGENT); }
__device__ __forceinline__ unsigned xb_xcc_id() { return (unsigned)__builtin_amdgcn_s_getreg((3 << 11) | 20) & 0xFu; }
#define XB_SPIN(cond, bar) do { unsigned _sp = 0; while (cond) { __builtin_amdgcn_s_sleep(1); \
    if ((++_sp & 255u) == 0u) { if (xb_ld(&(bar)[XB_TMO])) break; if (_sp > XB_SPIN_CAP) { atomicAdd(&(bar)[XB_TMO], 1u); break; } } } } while (0)
struct XcdBarrier { unsigned* bar; unsigned x; volatile LAS unsigned* st; };
__device__ __forceinline__ XcdBarrier xcd_barrier_post(unsigned* bar, volatile LAS unsigned* st) {
    XcdBarrier b; b.bar = bar; b.x = xb_xcc_id(); b.st = st;
    if (threadIdx.x == 0) (void)xb_add(&bar[XB_XCNT(b.x)], 1u);
    return b;
}
__device__ __forceinline__ void xcd_barrier_complete(unsigned* bar, unsigned x, unsigned& nloc, unsigned& nx) {
    const unsigned G = gridDim.x * gridDim.y * gridDim.z;
    unsigned sum, cnt, mine, sp = 0u;
    for (;;) {
        sum = 0u; cnt = 0u; mine = 0u;
#pragma unroll
        for (unsigned j = 0; j < 16; ++j) { const unsigned c = xb_ld(&bar[XB_XCNT(j)]); sum += c; cnt += (c > 0u) ? 1u : 0u; mine = (j == x) ? c : mine; }
        if (sum == G) break;
        __builtin_amdgcn_s_sleep(1);
        if ((++sp & 255u) == 0u) { if (xb_ld(&bar[XB_TMO])) break; if (sp > XB_SPIN_CAP) { atomicAdd(&bar[XB_TMO], 1u); break; } }
    }
    nloc = mine > 0u ? mine : 1u; nx = cnt > 0u ? cnt : 1u;
}
__device__ __forceinline__ void xcd_barrier(const XcdBarrier& b) {
    asm volatile("s_waitcnt vmcnt(0)" ::: "memory");
    __syncthreads();
    if (threadIdx.x == 0) {
        unsigned* bar = b.bar;
        __builtin_amdgcn_s_waitcnt(0);
        unsigned nloc = b.st[0], nx = b.st[1];
        if (nloc == 0u) { xcd_barrier_complete(bar, b.x, nloc, nx); b.st[0] = nloc; b.st[1] = nx; }
        const unsigned old = xb_add(&bar[XB_XSUB(b.x)], 1u);
        const unsigned gen = old / nloc;
        if (old + 1u == (gen + 1u) * nloc) {
            __builtin_amdgcn_fence(__ATOMIC_RELEASE, "agent");
            asm volatile("s_waitcnt vmcnt(0)" ::: "memory");
            const unsigned og = xb_add(&bar[XB_TOP], 1u);
            const unsigned tg = og / nx;
            if (og + 1u == (tg + 1u) * nx) xb_add(&bar[XB_TOPGEN], 1u);
            else XB_SPIN(xb_ld(&bar[XB_TOPGEN]) == tg, bar);
            __builtin_amdgcn_fence(__ATOMIC_ACQUIRE, "agent");
            xb_add(&bar[XB_XGEN(b.x)], 1u);
            asm volatile("s_waitcnt vmcnt(0)" ::: "memory");
        } else {
            XB_SPIN(xb_ld(&bar[XB_XGEN(b.x)]) == gen, bar);
            __builtin_amdgcn_fence(__ATOMIC_ACQUIRE, "agent");
            asm volatile("s_waitcnt vmcnt(0)" ::: "memory");
        }
    }
    __syncthreads();
}

namespace pg8 {
constexpr int BM = 256, BK = 64, HALF = 128, HTB = HALF * BK * 2, STAGE_BYTES = 8 * HTB, NXCD = 8, WGM = 8;
__host__ __device__ __forceinline__ int lds_byte(int r, int c) { const int st = (r >> 4) * 2 + (c >> 5), rr = r & 15, cc = c & 31, ob = rr * 64 + cc * 2; return st * 1024 + (ob ^ (((ob >> 9) & 1) << 5)); }
__host__ __device__ __forceinline__ void stage_rc(int b, int& R, int& C) { const int st = b / 1024, sb = b % 1024, swz = sb ^ (((sb >> 9) & 1) << 5); R = (st >> 1) * 16 + swz / 64; C = (st & 1) * 32 + (swz % 64) / 2; }
__host__ __device__ __forceinline__ int perm32(int rho) { const int n = rho >> 4, i = rho & 15; return 8 * (i >> 2) + 4 * n + (i & 3); }

struct Unit { int pm, pn; int arow; size_t boff; int e, lt, nvalid; const int* gidx; };

__device__ __forceinline__ void tile_order(int L, int nM, int nN, int& pm, int& pn) {
    const int nwg = nM * nN;
    int wgid = L; { const int q = nwg / NXCD, r = nwg % NXCD, xcd = wgid % NXCD, off = wgid / NXCD; wgid = (xcd < r ? xcd * (q + 1) : r * (q + 1) + (xcd - r) * q) + off; }
    const int nig = WGM * nN, gid = wgid / nig, fm = gid * WGM, gsz = (nM - fm) < WGM ? (nM - fm) : WGM;
    pm = fm + ((wgid % nig) % gsz); pn = (wgid % nig) / gsz;
}

#if !GEMM_NAIVE
template <class Epi, class Sched, bool GATHER, bool ALIGN_EPI>
__device__ __forceinline__ void gemm_phase(LAS unsigned char* lds, const bf16* A, const bf16* Bt, const int K, const Sched& S, const Epi& E) {
    const int tid = threadIdx.x, wid = __builtin_amdgcn_readfirstlane(tid >> 6), lane = tid & 63, wr = wid >> 2, wc = wid & 3, fr = lane & 15, fq = lane >> 4;
    const int nt = K / BK;
    unsigned voffA[2][2], voffB[2]; int Rr[2], Cc[2];
#pragma unroll
    for (int i = 0; i < 2; ++i) { int R, C; stage_rc(tid * 16 + i * 8192, R, C); Rr[i] = R; Cc[i] = C; const int Rb = Epi::PERM ? ((R & ~31) + perm32(R & 31)) : R;
        voffB[i] = (unsigned)(Rb * K + C) * 2u;
        voffA[0][i] = (unsigned)(R * K + C) * 2u; voffA[1][i] = (unsigned)((R + HALF) * K + C) * 2u; }
    const size_t kstep = (size_t)(BK * 2);
    const size_t hstepB = (size_t)HALF * K * 2;
    const unsigned ldsw = (unsigned)wid * 1024u;
    const int aoff = lds_byte(wr * 64 + fr, fq * 8), boff = lds_byte(wc * 32 + fr, fq * 8);
#define PG8_SA(b, h) (((b) * 2 + (h)) * HTB)
#define PG8_SB(b, h) ((4 + (b) * 2 + (h)) * HTB)
#define PG8_STAGE_A(bufoff, kb, h) do { _Pragma("unroll") for (int _i = 0; _i < 2; ++_i) \
        __builtin_amdgcn_global_load_lds((const unsigned*)((const char*)(kb) + voffA[h][_i]), (LAS unsigned*)(lds + (bufoff) + ldsw + _i * 8192), 16, 0, 0); } while (0)
#define PG8_STAGE_B(bufoff, kb, h) do { _Pragma("unroll") for (int _i = 0; _i < 2; ++_i) \
        __builtin_amdgcn_global_load_lds((const unsigned*)((const char*)(kb) + (size_t)(h) * hstepB + voffB[_i]), (LAS unsigned*)(lds + (bufoff) + ldsw + _i * 8192), 16, 0, 0); } while (0)
#define PG8_LDA(dst, b, h) do { _Pragma("unroll") for (int m = 0; m < 4; ++m) _Pragma("unroll") for (int k = 0; k < 2; ++k) dst[m][k] = *(const LAS bf16x8*)(lds + PG8_SA(b, h) + aoff + m * 2048 + k * 1024); } while (0)
#define PG8_LDB(dst, b, h) do { _Pragma("unroll") for (int n = 0; n < 2; ++n) _Pragma("unroll") for (int k = 0; k < 2; ++k) dst[n][k] = *(const LAS bf16x8*)(lds + PG8_SB(b, h) + boff + n * 2048 + k * 1024); } while (0)
#define PG8_MMA(ai, bj, At, Bt_) do { __builtin_amdgcn_s_setprio(1); _Pragma("unroll") for (int m = 0; m < 4; ++m) _Pragma("unroll") for (int n = 0; n < 2; ++n) _Pragma("unroll") for (int k = 0; k < 2; ++k) \
        acc[ai][bj][m][n] = __builtin_amdgcn_mfma_f32_16x16x32_bf16(Bt_[n][k], At[m][k], acc[ai][bj][m][n], 0, 0, 0); __builtin_amdgcn_s_setprio(0); } while (0)
#define PG8_WAIT_V(n) asm volatile("s_waitcnt vmcnt(" #n ")" ::: "memory")
#define PG8_WAIT_L(n) asm volatile("s_waitcnt lgkmcnt(" #n ")" ::: "memory")
#define PG8_BAR __builtin_amdgcn_s_barrier()
#define PG8_SCHED __builtin_amdgcn_sched_barrier(0)
#define PG8_GIDX(u, dst) do { _Pragma("unroll") for (int _h = 0; _h < 2; ++_h) _Pragma("unroll") for (int _i = 0; _i < 2; ++_i) { const int _row = _h * HALF + Rr[_i]; \
        const int _tok = (_row < (u).nvalid) ? ((u).gidx[_row] >> 2) : 0; dst[_h][_i] = (unsigned)(_tok * K + Cc[_i]) * 2u; } } while (0)
    Unit cur, nxt; int ui = 0;
    if (!S.next(0, cur)) return;
    f32x4 acc[2][2][4][2];
#pragma unroll
    for (int a = 0; a < 2; ++a)
#pragma unroll
        for (int b = 0; b < 2; ++b)
#pragma unroll
            for (int m = 0; m < 4; ++m)
#pragma unroll
                for (int n = 0; n < 2; ++n) acc[a][b][m][n] = (f32x4){0.f, 0.f, 0.f, 0.f};
    bf16x8 At[4][2], B0[2][2], B1[2][2];
    unsigned voffN[2][2] = {{0u, 0u}, {0u, 0u}};
    if constexpr (GATHER) { PG8_GIDX(cur, voffA); }
    const char* cA = GATHER ? (const char*)A : (const char*)A + (size_t)cur.arow * K * 2; const char* cB = (const char*)Bt + cur.boff;
    PG8_STAGE_B(PG8_SB(0, 0), cB, 0); PG8_STAGE_B(PG8_SB(0, 1), cB, 1); PG8_STAGE_A(PG8_SA(0, 0), cA, 0); PG8_STAGE_A(PG8_SA(0, 1), cA, 1);
    if (wr == 1) PG8_BAR;
    PG8_WAIT_V(2); PG8_BAR;
    PG8_STAGE_B(PG8_SB(1, 0), cB + kstep, 0); PG8_STAGE_A(PG8_SA(1, 0), cA + kstep, 0); PG8_STAGE_B(PG8_SB(1, 1), cB + kstep, 1);
    PG8_WAIT_V(6); PG8_BAR;
    for (;;) {
        const bool has_next = S.next(ui + 1, nxt);
        if constexpr (GATHER) { if (has_next) { PG8_GIDX(nxt, voffN); } }
        const char* nA = has_next ? (GATHER ? (const char*)A : (const char*)A + (size_t)nxt.arow * K * 2) : cA; const char* nB = has_next ? (const char*)Bt + nxt.boff : cB;
        for (int t = 0; t < nt; t += 2) {
            const bool last = (t == nt - 2);
            const char* a1 = cA + (size_t)(t + 1) * kstep;
            const char* a2 = last ? nA : cA + (size_t)(t + 2) * kstep; const char* b2 = last ? nB : cB + (size_t)(t + 2) * kstep;
            const char* a3 = a2 + kstep; const char* b3 = b2 + kstep;
            PG8_LDB(B0, 0, 0); PG8_LDB(B1, 0, 1); PG8_SCHED; PG8_LDA(At, 0, 0); PG8_STAGE_A(PG8_SA(1, 1), a1, 1);
            if constexpr (GATHER) { if (last && has_next) {
#pragma unroll
                for (int h = 0; h < 2; ++h)
#pragma unroll
                    for (int i = 0; i < 2; ++i) voffA[h][i] = voffN[h][i]; } }
            PG8_WAIT_V(8); PG8_WAIT_L(0); PG8_BAR; PG8_MMA(0, 0, At, B0); PG8_MMA(0, 1, At, B1); PG8_BAR; PG8_SCHED;
            PG8_LDA(At, 0, 1); PG8_STAGE_B(PG8_SB(0, 0), b2, 0); PG8_STAGE_B(PG8_SB(0, 1), b2, 1); PG8_STAGE_A(PG8_SA(0, 0), a2, 0);
            PG8_WAIT_V(8); PG8_WAIT_L(0); PG8_BAR; PG8_MMA(1, 0, At, B0); PG8_MMA(1, 1, At, B1); PG8_BAR; PG8_SCHED;
            PG8_LDB(B0, 1, 0); PG8_LDB(B1, 1, 1); PG8_SCHED; PG8_LDA(At, 1, 0); PG8_STAGE_A(PG8_SA(0, 1), a2, 1);
            PG8_WAIT_V(8); PG8_WAIT_L(0); PG8_BAR; PG8_MMA(0, 0, At, B0); PG8_MMA(0, 1, At, B1); PG8_BAR; PG8_SCHED;
            PG8_LDA(At, 1, 1); PG8_STAGE_B(PG8_SB(1, 0), b3, 0); PG8_STAGE_B(PG8_SB(1, 1), b3, 1); PG8_STAGE_A(PG8_SA(1, 0), a3, 0);
            PG8_WAIT_V(8); PG8_WAIT_L(0); PG8_BAR; PG8_MMA(1, 0, At, B0); PG8_MMA(1, 1, At, B1); PG8_BAR; PG8_SCHED;
        }
        if constexpr (ALIGN_EPI) { if (wr == 0) PG8_BAR; }
        E(acc, cur, wr, wc, fr, fq);
        if (!has_next) break;
#pragma unroll
        for (int a = 0; a < 2; ++a)
#pragma unroll
            for (int b = 0; b < 2; ++b)
#pragma unroll
                for (int m = 0; m < 4; ++m)
#pragma unroll
                    for (int n = 0; n < 2; ++n) acc[a][b][m][n] = (f32x4){0.f, 0.f, 0.f, 0.f};
        cur = nxt; cA = nA; cB = nB; ++ui;
        if constexpr (ALIGN_EPI) { if (wr == 1) PG8_BAR; }
    }
    PG8_WAIT_V(0);
    if constexpr (!ALIGN_EPI) { if (wr == 0) PG8_BAR; }
    PG8_BAR;
#undef PG8_SA
#undef PG8_SB
#undef PG8_STAGE_A
#undef PG8_STAGE_B
#undef PG8_LDA
#undef PG8_LDB
#undef PG8_MMA
#undef PG8_WAIT_V
#undef PG8_WAIT_L
#undef PG8_BAR
#undef PG8_SCHED
#undef PG8_GIDX
}
#else
template <class Epi, class Sched, bool GATHER, bool ALIGN_EPI>
__device__ __forceinline__ void gemm_phase(LAS unsigned char* lds, const bf16* A, const bf16* Bt, const int K, const Sched& S, const Epi& E) {
    const int tid = threadIdx.x, wid = __builtin_amdgcn_readfirstlane(tid >> 6), lane = tid & 63, wr = wid >> 2, wc = wid & 3, fr = lane & 15, fq = lane >> 4;
    constexpr int PITCH = 66;
    LAS bf16* As = (LAS bf16*)lds; LAS bf16* Bs = (LAS bf16*)(lds + 256 * PITCH * 2);
    Unit u;
    for (int ui = 0; S.next(ui, u); ++ui) {
        f32x4 acc[2][2][4][2];
#pragma unroll
        for (int a = 0; a < 2; ++a)
#pragma unroll
            for (int b = 0; b < 2; ++b)
#pragma unroll
                for (int m = 0; m < 4; ++m)
#pragma unroll
                    for (int n = 0; n < 2; ++n) acc[a][b][m][n] = (f32x4){0.f, 0.f, 0.f, 0.f};
        for (int kt = 0; kt < K; kt += 64) {
            __syncthreads();
            for (int q = tid; q < 2048; q += 512) { const int row = q >> 3, c8 = (q & 7) * 8;
                int arow; if (GATHER) arow = (row < u.nvalid) ? (u.gidx[row] >> 2) : 0; else arow = u.arow + row;
                const v4u va = *(const v4u*)(A + (size_t)arow * K + kt + c8);
                LAS unsigned* da = (LAS unsigned*)(As + row * PITCH + c8); da[0] = va.x; da[1] = va.y; da[2] = va.z; da[3] = va.w;
                const v4u vb = *(const v4u*)((const char*)Bt + u.boff + ((size_t)row * K + kt + c8) * 2);
                LAS unsigned* db = (LAS unsigned*)(Bs + row * PITCH + c8); db[0] = vb.x; db[1] = vb.y; db[2] = vb.z; db[3] = vb.w; }
            __syncthreads();
            for (int k = 0; k < 64; ++k) {
                float av[2][4], bv[2][2][4];
#pragma unroll
                for (int ai = 0; ai < 2; ++ai)
#pragma unroll
                    for (int m = 0; m < 4; ++m) av[ai][m] = bflo((unsigned)As[(ai * 128 + wr * 64 + m * 16 + fr) * PITCH + k]);
#pragma unroll
                for (int bj = 0; bj < 2; ++bj)
#pragma unroll
                    for (int n = 0; n < 2; ++n)
#pragma unroll
                        for (int j = 0; j < 4; ++j) { const int col = bj * 128 + wc * 32 + (Epi::PERM ? (8 * fq + 4 * n + j) : (16 * n + 4 * fq + j)); bv[bj][n][j] = bflo((unsigned)Bs[col * PITCH + k]); }
#pragma unroll
                for (int ai = 0; ai < 2; ++ai)
#pragma unroll
                    for (int bj = 0; bj < 2; ++bj)
#pragma unroll
                        for (int m = 0; m < 4; ++m)
#pragma unroll
                            for (int n = 0; n < 2; ++n)
#pragma unroll
                                for (int j = 0; j < 4; ++j) acc[ai][bj][m][n][j] += av[ai][m] * bv[bj][n][j];
            }
        }
        E(acc, u, wr, wc, fr, fq);
    }
    __syncthreads();
}
#endif

struct SchedIn {
    int G, c;
    __device__ __forceinline__ bool next(int i, Unit& u) const {
        const int L = i * G + c; constexpr int NL = 128 * 7;
        if (L >= NL + 8) return false;
        if (L < NL) tile_order(L, 128, 7, u.pm, u.pn); else { u.pm = 128 + (L - NL); u.pn = 2; }
        u.arow = u.pm * 256; u.boff = (size_t)u.pn * 256 * DM * 2; u.e = 0; u.lt = 0; u.nvalid = 256; u.gidx = nullptr; return true;
    }
};
struct SchedOut {
    int G, c;
    __device__ __forceinline__ bool next(int i, Unit& u) const {
        const int L = i * G + c; if (L >= 128 * 4) return false;
        tile_order(L, 128, 4, u.pm, u.pn);
        u.arow = u.pm * 256; u.boff = (size_t)u.pn * 256 * DM * 2; u.e = 0; u.lt = 0; u.nvalid = 256; u.gidx = nullptr; return true;
    }
};
template <int NN> struct SchedMoe {
    int G, c; const LAS unsigned char* tile_e; const LAS int* tab; const int* rowdst;
    __device__ __forceinline__ bool next(int i, Unit& u) const {
        const int ntiles = tab[65]; const int L = i * G + c; if (L >= ntiles * NN) return false;
        tile_order(L, ntiles, NN, u.pm, u.pn);
        const int e = tile_e[u.pm]; u.e = e; u.lt = u.pm - tab[32 + e];
        const int rem = tab[e] - u.lt * 256; u.nvalid = rem < 256 ? rem : 256;
        u.gidx = rowdst + (size_t)e * ECAP + u.lt * 256;
        u.arow = u.pm * 256; u.boff = ((size_t)e * NN * 256 + (size_t)u.pn * 256) * DM * 2; return true;
    }
};

struct EpiInProj {
    static constexpr bool PERM = true;
    const float* bias; bf16 *Q, *Kx, *V, *KC, *VC, *U, *GV; const float* rope;
    __device__ __forceinline__ void operator()(const f32x4 (&acc)[2][2][4][2], const Unit& u, int wr, int wc, int fr, int fq) const {
        const int row0 = u.pm * BM + wr * 64 + fr, colt = wc * 32 + 8 * fq, pn = u.pn;
        f32x4 bv[2][2];
#pragma unroll
        for (int bj = 0; bj < 2; ++bj)
#pragma unroll
            for (int n = 0; n < 2; ++n) bv[bj][n] = *(const f32x4*)(bias + pn * 256 + bj * HALF + colt + 4 * n);
        if (pn <= 2) {
            const bool ctxrow = u.pm >= 128; const bool upper = (fq >> 1) != 0;
#pragma unroll
            for (int ai = 0; ai < 2; ++ai)
#pragma unroll
                for (int m = 0; m < 4; ++m) {
                    const int row = row0 + ai * HALF + m * 16; const int t = row & (SEQ - 1); const int pos = (wc & 1) ? (t & 63) : (t >> 6);
                    const f32x4 c0 = *(const f32x4*)(rope + pos * 16 + 8 * (fq & 1)), c1 = *(const f32x4*)(rope + pos * 16 + 8 * (fq & 1) + 4);
                    const f32x4 s0 = *(const f32x4*)(rope + 1024 + pos * 16 + 8 * (fq & 1)), s1 = *(const f32x4*)(rope + 1024 + pos * 16 + 8 * (fq & 1) + 4);
#pragma unroll
                    for (int bj = 0; bj < 2; ++bj) {
                        const bool dorope = (pn < 2) || (bj == 0 && !ctxrow);
                        const f32x4 vin0 = acc[ai][bj][m][0] + bv[bj][0], vin1 = acc[ai][bj][m][1] + bv[bj][1];
                        f32x4 v[2]; v[0] = vin0; v[1] = vin1;
                        if (dorope) {
                            float ro[2][4];
#pragma unroll
                            for (int n = 0; n < 2; ++n)
#pragma unroll
                                for (int j = 0; j < 4; ++j) {
                                    const float xin = n ? vin1[j] : vin0[j];
                                    const unsigned xb = __builtin_bit_cast(unsigned, xin);
                                    auto rr = __builtin_amdgcn_permlane32_swap(xb, xb, false, false);
                                    const float x1 = __builtin_bit_cast(float, (unsigned)rr[0]), x2 = __builtin_bit_cast(float, (unsigned)rr[1]);
                                    const float cs = n ? c1[j] : c0[j], sn = n ? s1[j] : s0[j];
                                    ro[n][j] = upper ? (x2 * cs + x1 * sn) : (x1 * cs - x2 * sn);
                                }
                            v[0] = (f32x4){ro[0][0], ro[0][1], ro[0][2], ro[0][3]}; v[1] = (f32x4){ro[1][0], ro[1][1], ro[1][2], ro[1][3]};
                        }
                        if (pn < 2) { v[0] = v[0] * QSCALE; v[1] = v[1] * QSCALE; }
                        v4u w; w.x = cvt_pk_bf16(v[0][0], v[0][1]); w.y = cvt_pk_bf16(v[0][2], v[0][3]); w.z = cvt_pk_bf16(v[1][0], v[1][1]); w.w = cvt_pk_bf16(v[1][2], v[1][3]);
                        bf16* dst;
                        if (pn < 2) dst = Q + (size_t)row * 512 + pn * 256 + bj * HALF + colt;
                        else if (!ctxrow) dst = (bj == 0 ? Kx : V) + (size_t)row * 128 + colt;
                        else dst = (bj == 0 ? KC : VC) + (size_t)(row - TT) * 128 + colt;
                        *(v4u*)dst = w;
                    }
                }
        } else {
            bf16* base = (pn < 5 ? U : GV) + ((pn - 3) & 1) * 256 + colt;
#pragma unroll
            for (int ai = 0; ai < 2; ++ai)
#pragma unroll
                for (int m = 0; m < 4; ++m) { const int row = row0 + ai * HALF + m * 16;
#pragma unroll
                    for (int bj = 0; bj < 2; ++bj) { f32x4 v0 = acc[ai][bj][m][0] + bv[bj][0], v1 = acc[ai][bj][m][1] + bv[bj][1];
#pragma unroll
                        for (int j = 0; j < 4; ++j) { v0[j] = gelu_tanh(v0[j]); v1[j] = gelu_tanh(v1[j]); }
                        v4u w; w.x = cvt_pk_bf16(v0[0], v0[1]); w.y = cvt_pk_bf16(v0[2], v0[3]); w.z = cvt_pk_bf16(v1[0], v1[1]); w.w = cvt_pk_bf16(v1[2], v1[3]);
                        *(v4u*)(base + (size_t)row * 512 + bj * HALF) = w; } }
        }
    }
};
struct EpiOut {
    static constexpr bool PERM = true;
    const float* bias; bf16* O;
    __device__ __forceinline__ void operator()(const f32x4 (&acc)[2][2][4][2], const Unit& u, int wr, int wc, int fr, int fq) const {
        const int row0 = u.pm * BM + wr * 64 + fr, col0 = u.pn * BM + wc * 32 + 8 * fq;
        f32x4 bv[2][2];
#pragma unroll
        for (int bj = 0; bj < 2; ++bj)
#pragma unroll
            for (int n = 0; n < 2; ++n) bv[bj][n] = *(const f32x4*)(bias + col0 + bj * HALF + 4 * n);
#pragma unroll
        for (int ai = 0; ai < 2; ++ai)
#pragma unroll
            for (int m = 0; m < 4; ++m) { bf16* rowp = O + (size_t)(row0 + ai * HALF + m * 16) * DM + col0;
#pragma unroll
                for (int bj = 0; bj < 2; ++bj) { const f32x4 v0 = acc[ai][bj][m][0] + bv[bj][0], v1 = acc[ai][bj][m][1] + bv[bj][1];
                    v4u w; w.x = cvt_pk_bf16(v0[0], v0[1]); w.y = cvt_pk_bf16(v0[2], v0[3]); w.z = cvt_pk_bf16(v1[0], v1[1]); w.w = cvt_pk_bf16(v1[2], v1[3]);
                    *(v4u*)(rowp + bj * HALF) = w; } }
    }
};
struct EpiSwiglu {
    static constexpr bool PERM = true;
    const float* bgu; bf16* ACT;
    __device__ __forceinline__ void operator()(const f32x4 (&acc)[2][2][4][2], const Unit& u, int wr, int wc, int fr, int fq) const {
        const int row0 = u.pm * BM + wr * 64 + fr, colt = u.pn * HALF + wc * 32 + 8 * fq;
        const float* bg = bgu + (size_t)u.e * 2048 + colt;
        f32x4 bgv[2], buv[2];
#pragma unroll
        for (int n = 0; n < 2; ++n) { bgv[n] = *(const f32x4*)(bg + 4 * n); buv[n] = *(const f32x4*)(bg + 1024 + 4 * n); }
#pragma unroll
        for (int ai = 0; ai < 2; ++ai)
#pragma unroll
            for (int m = 0; m < 4; ++m) { f32x4 o[2];
#pragma unroll
                for (int n = 0; n < 2; ++n) { const f32x4 g4 = acc[ai][0][m][n] + bgv[n], u4 = acc[ai][1][m][n] + buv[n];
#pragma unroll
                    for (int j = 0; j < 4; ++j) { const float g = fminf(g4[j], 7.0f), up = fminf(fmaxf(u4[j], -7.0f), 7.0f);
                        o[n][j] = (up + 1.0f) * g * __builtin_amdgcn_rcpf(1.0f + __builtin_amdgcn_exp2f(-1.702f * LOG2E * g)); } }
                v4u w; w.x = cvt_pk_bf16(o[0][0], o[0][1]); w.y = cvt_pk_bf16(o[0][2], o[0][3]); w.z = cvt_pk_bf16(o[1][0], o[1][1]); w.w = cvt_pk_bf16(o[1][2], o[1][3]);
                *(v4u*)(ACT + (size_t)(row0 + ai * HALF + m * 16) * FF + colt) = w; }
    }
};
struct EpiDown {
    static constexpr bool PERM = true;
    const float* bd; bf16* Y4;
    __device__ __forceinline__ void operator()(const f32x4 (&acc)[2][2][4][2], const Unit& u, int wr, int wc, int fr, int fq) const {
        const int rl0 = wr * 64 + fr, col0 = u.pn * BM + wc * 32 + 8 * fq;
        const float* bp = bd + (size_t)u.e * DM + col0;
        f32x4 bv[2][2];
#pragma unroll
        for (int bj = 0; bj < 2; ++bj)
#pragma unroll
            for (int n = 0; n < 2; ++n) bv[bj][n] = *(const f32x4*)(bp + bj * HALF + 4 * n);
#pragma unroll
        for (int ai = 0; ai < 2; ++ai)
#pragma unroll
            for (int m = 0; m < 4; ++m) { const int rl = rl0 + ai * HALF + m * 16;
                if (rl < u.nvalid) { const int dst = u.gidx[rl]; bf16* rowp = Y4 + (size_t)dst * DM + col0;
#pragma unroll
                    for (int bj = 0; bj < 2; ++bj) { const f32x4 v0 = acc[ai][bj][m][0] + bv[bj][0], v1 = acc[ai][bj][m][1] + bv[bj][1];
                        v4u w; w.x = cvt_pk_bf16(v0[0], v0[1]); w.y = cvt_pk_bf16(v0[2], v0[3]); w.z = cvt_pk_bf16(v1[0], v1[1]); w.w = cvt_pk_bf16(v1[2], v1[3]);
                        *(v4u*)(rowp + bj * HALF) = w; } } }
    }
};
}

constexpr int NWAVES = 8;
struct Frame {
    LAS unsigned char* lds;
    gu32* ctl;
    int tid, lane, wave;
    int vcu, G;
    const float* in[27]; float* out; unsigned char* ws;
};

__device__ __forceinline__ void p0_transpose_item(const float* W, int K, int N, bf16* WT, int drow0, int k0, int n0, LAS float* scr, int lane) {
#pragma unroll 8
    for (int i = 0; i < 32; ++i) { const int kk = 2 * i + (lane >> 5); scr[kk * 33 + (lane & 31)] = W[(size_t)(k0 + kk) * N + n0 + (lane & 31)]; }
    LDS_WAIT(); asm volatile("" ::: "memory");
    const int c = lane & 7;
#pragma unroll
    for (int j = 0; j < 4; ++j) { const int n = (lane >> 3) + 8 * j; const LAS float* s = scr + (8 * c) * 33 + n;
        v4u o; o.x = pk2(s[0 * 33], s[1 * 33]); o.y = pk2(s[2 * 33], s[3 * 33]); o.z = pk2(s[4 * 33], s[5 * 33]); o.w = pk2(s[6 * 33], s[7 * 33]);
        *(GAS v4u*)(WT + (size_t)(drow0 + n) * K + k0 + 8 * c) = o; }
    LDS_WAIT(); asm volatile("" ::: "memory");
}
__device__ __forceinline__ void p0_prologue(Frame& F) {
    const float* c = F.in[1]; const float* c_ctx = F.in[3]; const float* w_ada = F.in[4]; const float* b_ada = F.in[5];
    float* MOD = (float*)(F.ws + WS_MOD);
    if ((int)blockIdx.x < NMOD / 32) {
        LAS float* sl = (LAS float*)F.lds;
        LAS float* red = (LAS float*)(F.lds + 9 * 1024 * 4);
        for (int q = F.tid; q < 9 * 1024; q += NWAVES * 64) { const float v = q < 8192 ? c[q] : c_ctx[q - 8192]; sl[q] = v / (1.0f + __expf(-v)); }
        __syncthreads();
        for (int item = blockIdx.x; item < NMOD / 32; item += F.G) {
            const int n0 = item * 32, col = F.lane & 31, kp = F.lane >> 5;
            float a[9];
#pragma unroll
            for (int r = 0; r < 9; ++r) a[r] = 0.f;
#pragma unroll 8
            for (int kk = 0; kk < 64; ++kk) { const int k = F.wave * 128 + 2 * kk + kp; const float wv = w_ada[(size_t)k * NMOD + n0 + col];
#pragma unroll
                for (int r = 0; r < 9; ++r) a[r] += sl[r * 1024 + k] * wv; }
#pragma unroll
            for (int r = 0; r < 9; ++r) { a[r] += __shfl_xor(a[r], 32); if (F.lane < 32) red[(F.wave * 9 + r) * 32 + col] = a[r]; }
            __syncthreads();
            if (F.tid < 9 * 32) { const int r = F.tid >> 5, cc = F.tid & 31; float s = b_ada[n0 + cc];
#pragma unroll
                for (int w = 0; w < 8; ++w) s += red[(w * 9 + r) * 32 + cc];
                MOD[r * NMOD + n0 + cc] = s; }
            __syncthreads();
        }
    }
    __syncthreads();
    if ((int)blockIdx.x == F.G - 1) {
        float* rope = (float*)(F.ws + WS_ROPE);
        for (int q = F.tid; q < 1024; q += NWAVES * 64) { const int pos = q >> 4, f = q & 15;
            const float inv = __builtin_amdgcn_exp2f(-(float)f * (13.287712379549449f / 16.0f));
            const float ang = (float)pos * inv; rope[q] = __cosf(ang); rope[1024 + q] = __sinf(ang); }
    }
    { const float* sw = F.in[15]; bf16* so = (bf16*)(F.ws + WS_SGUW);
      for (int q = blockIdx.x * NWAVES * 64 + F.tid; q < 8 * 128 * 128 / 4; q += F.G * NWAVES * 64) { const f32x4 v = *(const f32x4*)(sw + 4 * q); v2u o; o.x = pk2(v[0], v[1]); o.y = pk2(v[2], v[3]); *(v2u*)(so + 4 * q) = o; } }
    LAS float* scr = (LAS float*)(F.lds + F.wave * 16384);
    const int gw = F.vcu * NWAVES + F.wave, NGW = F.G * NWAVES;
    constexpr int I_IN = 16 * (NIN / 32), I_OUT = 16 * (DM / 32), I_GU = 16 * (2048 / 32), I_D = 16 * (DM / 32);
    constexpr int NITEMS = I_IN + I_OUT + NE * I_GU + NE * I_D;
    bf16* win = (bf16*)(F.ws + WS_WIN); bf16* wout = (bf16*)(F.ws + WS_WOUT); bf16* wgu = (bf16*)(F.ws + WS_WGU); bf16* wd = (bf16*)(F.ws + WS_WD);
    for (int it = gw; it < NITEMS; it += NGW) {
        int r = it;
        if (r < I_IN) { const int nb = NIN / 32; p0_transpose_item(F.in[10], DM, NIN, win, 32 * (r % nb), 64 * (r / nb), 32 * (r % nb), scr, F.lane); continue; } r -= I_IN;
        if (r < I_OUT) { const int nb = DM / 32; p0_transpose_item(F.in[19], DM, DM, wout, 32 * (r % nb), 64 * (r / nb), 32 * (r % nb), scr, F.lane); continue; } r -= I_OUT;
        if (r < NE * I_GU) { const int e = r / I_GU, q = r % I_GU, nb = 2048 / 32, n0 = 32 * (q % nb), k0 = 64 * (q / nb);
            const int drow = n0 < 1024 ? (n0 >> 7) * 256 + (n0 & 127) : ((n0 - 1024) >> 7) * 256 + 128 + ((n0 - 1024) & 127);
            p0_transpose_item(F.in[23] + (size_t)e * DM * 2048, DM, 2048, wgu + (size_t)e * 2048 * DM, drow, k0, n0, scr, F.lane); continue; } r -= NE * I_GU;
        { const int e = r / I_D, q = r % I_D, nb = DM / 32, n0 = 32 * (q % nb), k0 = 64 * (q / nb);
            p0_transpose_item(F.in[25] + (size_t)e * FF * DM, FF, DM, wd + (size_t)e * DM * FF, n0, k0, n0, scr, F.lane); }
    }
}

__device__ __forceinline__ void p1_prenorm(Frame& F) {
    const float* MOD = (const float*)(F.ws + WS_MOD); const float* g = F.in[6]; bf16* H = (bf16*)(F.ws + WS_H);
    const int gw = F.vcu * NWAVES + F.wave, NGW = F.G * NWAVES;
    for (int m = gw; m < TT + TC; m += NGW) {
        const float* xrow = m < TT ? F.in[0] + (size_t)m * DM : F.in[2] + (size_t)(m - TT) * DM;
        const float* md = MOD + (m < TT ? (m >> 12) : 8) * NMOD;
        const GAS f32x4* xr = (const GAS f32x4*)xrow + F.lane;
        f32x4 v[4]; float s = 0.f;
#pragma unroll
        for (int j = 0; j < 4; ++j) { v[j] = xr[64 * j]; s += (v[j].x * v[j].x + v[j].y * v[j].y) + (v[j].z * v[j].z + v[j].w * v[j].w); }
        const float rstd = 1.0f / sqrtf(wave_sum(s) * (1.0f / DM) + EPS);
        GAS v2u* o8 = (GAS v2u*)(H + (size_t)m * DM) + F.lane;
#pragma unroll
        for (int j = 0; j < 4; ++j) { const int col = 4 * F.lane + 256 * j;
            const f32x4 gg = *(const f32x4*)(g + col), sh = *(const f32x4*)(md + col), sc = *(const f32x4*)(md + DM + col);
            const f32x4 y = v[j] * rstd * gg * (sc + 1.0f) + sh;
            v2u o; o.x = pk2(y.x, y.y); o.y = pk2(y.z, y.w); o8[64 * j] = o; }
    }
}

__device__ __forceinline__ int crow(int r, int hi) { return (r & 3) + 8 * (r >> 2) + 4 * hi; }
typedef short v4i16_t __attribute__((ext_vector_type(4)));
__device__ __forceinline__ s16x4 vtr(const LAS unsigned char* p) { return __builtin_bit_cast(s16x4, __builtin_amdgcn_ds_read_tr16_b64_v4i16((LAS v4i16_t*)p)); }
__device__ __forceinline__ float swapsum(float v) { auto rr = __builtin_amdgcn_permlane32_swap(__builtin_bit_cast(unsigned, v), __builtin_bit_cast(unsigned, v), false, false); return __builtin_bit_cast(float, (unsigned)rr[0]) + __builtin_bit_cast(float, (unsigned)rr[1]); }
__device__ __forceinline__ float swapmax(float v) { auto rr = __builtin_amdgcn_permlane32_swap(__builtin_bit_cast(unsigned, v), __builtin_bit_cast(unsigned, v), false, false); return fmaxf(__builtin_bit_cast(float, (unsigned)rr[0]), __builtin_bit_cast(float, (unsigned)rr[1])); }

__device__ __forceinline__ void attn_unit(Frame& F, int b, int pb) {
    const bf16* Q = (const bf16*)(F.ws + WS_Q); const bf16* Kx = (const bf16*)(F.ws + WS_K); const bf16* Vx = (const bf16*)(F.ws + WS_V);
    const bf16* KC = (const bf16*)(F.ws + WS_KC); const bf16* VC = (const bf16*)(F.ws + WS_VC); bf16* O = (bf16*)(F.ws + WS_O);
    const float* sink = F.in[12]; const float* g_attn = F.in[17];
    const int lane = F.lane, r32 = lane & 31, hi = lane >> 5, wid = F.wave, hq = wid, kvh = wid >> 2;
    const int p0 = pb * 32, rowbase = b * SEQ;
    LAS unsigned char* lds = F.lds;
    LAS float* xch = (LAS float*)(F.lds + L_XCH);
    bf16x8 qr[4];
    { const bf16* qp = Q + (size_t)(rowbase + p0 + r32) * 512 + hq * 64 + hi * 8;
#pragma unroll
      for (int d0 = 0; d0 < 4; ++d0) qr[d0] = *(const bf16x8*)(qp + d0 * 16); }
    const int tlo = (p0 < 65) ? (p0 == 0 ? 2 : 1) : 0;
    const int thi = (p0 >= SEQ - 64) ? 2 : ((p0 >= SEQ - 128) ? 3 : 4);
    const int nb = thi - tlo + 1, ntile = nb + 4;
    v4u kreg[2], vreg[2];
#define ATT_LOAD_TILE(s_) do { const bf16 *kb_, *vb_; int krow_, vrow_; \
        if ((s_) < nb) { const int kp0_ = p0 - 128 + 64 * (tlo + (s_)); int kr_ = kp0_ + lane; kr_ = kr_ < 0 ? 0 : (kr_ > SEQ - 1 ? SEQ - 1 : kr_); \
            int vr_ = kp0_ + 16 * (wid & 3) + (lane >> 2); vr_ = vr_ < 0 ? 0 : (vr_ > SEQ - 1 ? SEQ - 1 : vr_); \
            kb_ = Kx + (size_t)rowbase * 128; vb_ = Vx + (size_t)rowbase * 128; krow_ = kr_; vrow_ = vr_; } \
        else { const int c0_ = 64 * ((s_) - nb); kb_ = KC + (size_t)b * LC * 128; vb_ = VC + (size_t)b * LC * 128; krow_ = c0_ + lane; vrow_ = c0_ + 16 * (wid & 3) + (lane >> 2); } \
        _Pragma("unroll") for (int i_ = 0; i_ < 2; ++i_) { kreg[i_] = *(const v4u*)(kb_ + (size_t)krow_ * 128 + i_ * 64 + 8 * wid); \
            vreg[i_] = *(const v4u*)(vb_ + (size_t)vrow_ * 128 + i_ * 64 + (wid >> 2) * 32 + (lane & 3) * 8); } } while (0)
#define ATT_WRITE_TILE(buf_) do { _Pragma("unroll") for (int i_ = 0; i_ < 2; ++i_) { *(LAS v4u*)(lds + (buf_) * 32768 + i_ * 8192 + wid * 1024 + lane * 16) = kreg[i_]; \
            *(LAS v4u*)(lds + (buf_) * 32768 + 16384 + i_ * 8192 + wid * 1024 + lane * 16) = vreg[i_]; } } while (0)
    ATT_LOAD_TILE(0); ATT_WRITE_TILE(0);
    float mrun = -INFINITY, lrun = 0.f; f32x16 o[2];
#pragma unroll
    for (int r = 0; r < 16; ++r) { o[0][r] = 0.f; o[1][r] = 0.f; }
    const int vlane = ((lane >> 4) & 1) * 32 + (lane & 3) * 8 + (4 * hi + ((lane & 15) >> 2)) * 64;
    for (int s = 0; s < ntile; ++s) {
        __syncthreads();
        if (s + 1 < ntile) ATT_LOAD_TILE(s + 1);
        const LAS unsigned char* Ks = lds + (s & 1) * 32768 + kvh * 8192;
        const LAS unsigned char* Vs = lds + (s & 1) * 32768 + 16384 + kvh * 8192;
        f32x16 p0v, p1v;
#pragma unroll
        for (int r = 0; r < 16; ++r) { p0v[r] = 0.f; p1v[r] = 0.f; }
        { const LAS unsigned char* kp = Ks + hi * 1024 + r32 * 16;
#pragma unroll
          for (int d0 = 0; d0 < 4; ++d0) { const bf16x8 k0 = *(const LAS bf16x8*)(kp + d0 * 2048), k1 = *(const LAS bf16x8*)(kp + d0 * 2048 + 512);
              p0v = __builtin_amdgcn_mfma_f32_32x32x16_bf16(k0, qr[d0], p0v, 0, 0, 0); p1v = __builtin_amdgcn_mfma_f32_32x32x16_bf16(k1, qr[d0], p1v, 0, 0, 0); } }
        if (s < nb) {
            const int kp0 = p0 - 128 + 64 * (tlo + s), qpos = p0 + r32;
#pragma unroll
            for (int r = 0; r < 16; ++r) { const int k0 = kp0 + crow(r, hi), k1 = k0 + 32;
                const bool v0 = (k0 >= 0) && (k0 < SEQ) && (k0 - qpos <= 128) && (qpos - k0 <= 128);
                const bool v1 = (k1 >= 0) && (k1 < SEQ) && (k1 - qpos <= 128) && (qpos - k1 <= 128);
                p0v[r] = v0 ? p0v[r] : -INFINITY; p1v[r] = v1 ? p1v[r] : -INFINITY; }
        }
        float tm = p0v[0];
#pragma unroll
        for (int r = 1; r < 16; ++r) tm = fmaxf(tm, p0v[r]);
#pragma unroll
        for (int r = 0; r < 16; ++r) tm = fmaxf(tm, p1v[r]);
        tm = swapmax(tm);
        const float mnew = fmaxf(mrun, tm);
        const float alpha = __builtin_amdgcn_exp2f(mrun - mnew);
        float ls = 0.f;
#pragma unroll
        for (int r = 0; r < 16; ++r) { p0v[r] = __builtin_amdgcn_exp2f(p0v[r] - mnew); p1v[r] = __builtin_amdgcn_exp2f(p1v[r] - mnew); ls += p0v[r] + p1v[r]; }
        lrun = lrun * alpha + ls; mrun = mnew;
#pragma unroll
        for (int r = 0; r < 16; ++r) { o[0][r] *= alpha; o[1][r] *= alpha; }
        v4u pw[4];
#pragma unroll
        for (int q = 0; q < 4; ++q) { pw[0][q] = cvt_pk_bf16(p0v[2 * q], p0v[2 * q + 1]); pw[1][q] = cvt_pk_bf16(p0v[8 + 2 * q], p0v[8 + 2 * q + 1]);
            pw[2][q] = cvt_pk_bf16(p1v[2 * q], p1v[2 * q + 1]); pw[3][q] = cvt_pk_bf16(p1v[8 + 2 * q], p1v[8 + 2 * q + 1]); }
#pragma unroll
        for (int dh = 0; dh < 2; ++dh)
#pragma unroll
            for (int ks = 0; ks < 4; ++ks) { const s16x4 lo = vtr(Vs + vlane + dh * 4096 + ks * 1024), hh = vtr(Vs + vlane + dh * 4096 + ks * 1024 + 512);
                const bf16x8 vf = (bf16x8){lo[0], lo[1], lo[2], lo[3], hh[0], hh[1], hh[2], hh[3]};
                o[dh] = __builtin_amdgcn_mfma_f32_32x32x16_bf16(vf, __builtin_bit_cast(bf16x8, pw[ks]), o[dh], 0, 0, 0); }
        if (s + 1 < ntile) ATT_WRITE_TILE((s + 1) & 1);
    }
    float lt = swapsum(lrun) + __builtin_amdgcn_exp2f(sink[hq] * LOG2E - mrun);
    const float inv = 1.0f / lt; float ssq = 0.f;
#pragma unroll
    for (int r = 0; r < 16; ++r) { o[0][r] *= inv; o[1][r] *= inv; ssq += o[0][r] * o[0][r] + o[1][r] * o[1][r]; }
    ssq = swapsum(ssq);
    if (hi == 0) xch[wid * 32 + r32] = ssq;
    __syncthreads();
    float tot = 0.f;
#pragma unroll
    for (int w = 0; w < 8; ++w) tot += xch[w * 32 + r32];
    const float rstd = 1.0f / sqrtf(tot * (1.0f / 512.0f) + EPS);
    bf16* orow = O + (size_t)(rowbase + p0 + r32) * DM + hq * 64;
#pragma unroll
    for (int dh = 0; dh < 2; ++dh)
#pragma unroll
        for (int rg = 0; rg < 4; ++rg) { const int d = 32 * dh + 8 * rg + 4 * hi; const f32x4 gg = *(const f32x4*)(g_attn + hq * 64 + d);
            v2u w; w.x = cvt_pk_bf16(o[dh][4 * rg] * rstd * gg[0], o[dh][4 * rg + 1] * rstd * gg[1]); w.y = cvt_pk_bf16(o[dh][4 * rg + 2] * rstd * gg[2], o[dh][4 * rg + 3] * rstd * gg[3]);
            *(v2u*)(orow + d) = w; }
    __syncthreads();
}

__device__ __forceinline__ void sgu_unit(Frame& F, int b, int ch) {
    const bf16* GV = (const bf16*)(F.ws + WS_GV); const bf16* U = (const bf16*)(F.ws + WS_U); const bf16* SW = (const bf16*)(F.ws + WS_SGUW); bf16* O = (bf16*)(F.ws + WS_O);
    const float* ln_g = F.in[13]; const float* ln_b = F.in[14]; const float* sgub = F.in[16]; const float* g_sgu = F.in[18];
    const int lane = F.lane, wid = F.wave, r0 = b * SEQ + ch * 128;
    LAS unsigned char* lds = F.lds; LAS float* xch = (LAS float*)(F.lds + L_XCH);
    { const int c0 = lane * 8; const f32x4 g0 = *(const f32x4*)(ln_g + c0), g1 = *(const f32x4*)(ln_g + c0 + 4), b0 = *(const f32x4*)(ln_b + c0), b1 = *(const f32x4*)(ln_b + c0 + 4);
      const int hh = lane >> 3, cc = (lane & 7) * 8;
      for (int jj = 0; jj < 16; ++jj) { const int j = wid * 16 + jj;
          const v4u raw = *(const v4u*)(GV + (size_t)(r0 + j) * 512 + c0);
          float x[8] = {bflo(raw.x), bfhi(raw.x), bflo(raw.y), bfhi(raw.y), bflo(raw.z), bfhi(raw.z), bflo(raw.w), bfhi(raw.w)};
          float s = 0.f;
#pragma unroll
          for (int q = 0; q < 8; ++q) s += x[q];
          const float mean = wave_sum(s) * (1.0f / 512.0f); float s2 = 0.f;
#pragma unroll
          for (int q = 0; q < 8; ++q) { x[q] -= mean; s2 += x[q] * x[q]; }
          const float rstd = 1.0f / sqrtf(wave_sum(s2) * (1.0f / 512.0f) + EPS);
          v4u o; o.x = cvt_pk_bf16(x[0] * rstd * g0[0] + b0[0], x[1] * rstd * g0[1] + b0[1]); o.y = cvt_pk_bf16(x[2] * rstd * g0[2] + b0[2], x[3] * rstd * g0[3] + b0[3]);
          o.z = cvt_pk_bf16(x[4] * rstd * g1[0] + b1[0], x[5] * rstd * g1[1] + b1[1]); o.w = cvt_pk_bf16(x[6] * rstd * g1[2] + b1[2], x[7] * rstd * g1[3] + b1[3]);
          *(LAS v4u*)(lds + hh * 16384 + ((j >> 3) * 2 + (cc >> 5)) * 512 + (j & 7) * 64 + (cc & 31) * 2) = o; } }
    __syncthreads();
    const int h = wid, kg = lane >> 4, il = lane & 15, q4 = il >> 2, p4 = il & 3;
    const LAS unsigned char* img = lds + h * 16384;
#pragma unroll 1
    for (int ip = 0; ip < 2; ++ip) {
        f32x4 acc[4][4];
#pragma unroll
        for (int cm = 0; cm < 4; ++cm)
#pragma unroll
            for (int in = 0; in < 4; ++in) acc[cm][in] = (f32x4){0.f, 0.f, 0.f, 0.f};
#pragma unroll 1
        for (int ks = 0; ks < 4; ++ks) {
            bf16x8 af[4], bfr[4];
#pragma unroll
            for (int cm = 0; cm < 4; ++cm) { const int off = ((4 * ks + kg) * 2 + (cm >> 1)) * 512 + q4 * 64 + (16 * (cm & 1) + 4 * p4) * 2;
                const s16x4 lo = vtr(img + off), hh2 = vtr(img + off + 256); af[cm] = (bf16x8){lo[0], lo[1], lo[2], lo[3], hh2[0], hh2[1], hh2[2], hh2[3]}; }
#pragma unroll
            for (int in = 0; in < 4; ++in) bfr[in] = *(const bf16x8*)(SW + (size_t)(h * 128 + 64 * ip + 16 * in + il) * 128 + 32 * ks + 8 * kg);
#pragma unroll
            for (int cm = 0; cm < 4; ++cm)
#pragma unroll
                for (int in = 0; in < 4; ++in) acc[cm][in] = __builtin_amdgcn_mfma_f32_16x16x32_bf16(af[cm], bfr[in], acc[cm][in], 0, 0, 0);
        }
#pragma unroll
        for (int in = 0; in < 4; ++in) { const int i = 64 * ip + 16 * in + il; const float bs = sgub[h * 128 + i]; float ss = 0.f;
#pragma unroll
            for (int cm = 0; cm < 4; ++cm) { const int c = h * 64 + 16 * cm + 4 * kg; const v2u ur = *(const v2u*)(U + (size_t)(r0 + i) * 512 + c);
                f32x4 v = acc[cm][in]; v[0] = (v[0] + bs) * bflo(ur.x); v[1] = (v[1] + bs) * bfhi(ur.x); v[2] = (v[2] + bs) * bflo(ur.y); v[3] = (v[3] + bs) * bfhi(ur.y);
                acc[cm][in] = v; ss += (v[0] * v[0] + v[1] * v[1]) + (v[2] * v[2] + v[3] * v[3]); }
            ss += __shfl_xor(ss, 16); ss += __shfl_xor(ss, 32);
            if (lane < 16) xch[h * 64 + 16 * in + il] = ss; }
        __syncthreads();
#pragma unroll
        for (int in = 0; in < 4; ++in) { const int i = 64 * ip + 16 * in + il; float tot = 0.f;
#pragma unroll
            for (int w = 0; w < 8; ++w) tot += xch[w * 64 + 16 * in + il];
            const float rstd = 1.0f / sqrtf(tot * (1.0f / 512.0f) + EPS);
#pragma unroll
            for (int cm = 0; cm < 4; ++cm) { const int c = h * 64 + 16 * cm + 4 * kg; const f32x4 gg = *(const f32x4*)(g_sgu + c); const f32x4 v = acc[cm][in];
                v2u w; w.x = cvt_pk_bf16(v[0] * rstd * gg[0], v[1] * rstd * gg[1]); w.y = cvt_pk_bf16(v[2] * rstd * gg[2], v[3] * rstd * gg[3]);
                *(v2u*)(O + (size_t)(r0 + i) * DM + 512 + c) = w; } }
        __syncthreads();
    }
}


__device__ __forceinline__ void naive_attn_token(Frame& F, int tok) {
    const bf16* Q = (const bf16*)(F.ws + WS_Q); const bf16* Kx = (const bf16*)(F.ws + WS_K); const bf16* Vx = (const bf16*)(F.ws + WS_V);
    const bf16* KC = (const bf16*)(F.ws + WS_KC); const bf16* VC = (const bf16*)(F.ws + WS_VC); bf16* O = (bf16*)(F.ws + WS_O);
    const int lane = F.lane, h = F.wave, kvh = h >> 2, b = tok >> 12, pos = tok & (SEQ - 1);
    LAS float* qs = (LAS float*)(F.lds) + h * 64; LAS float* sc = (LAS float*)(F.lds + 4096) + h * 768; LAS float* xs = (LAS float*)(F.lds + L_XCH);
    qs[lane] = bflo((unsigned)Q[(size_t)tok * 512 + h * 64 + lane]);
    __syncthreads();
    const int lo = pos - 128 < 0 ? 0 : pos - 128, hi = pos + 128 > SEQ - 1 ? SEQ - 1 : pos + 128, nband = hi - lo + 1, nk = nband + LC;
    float mx = F.in[12][h] * LOG2E;
    for (int base = 0; base < nk; base += 64) { const int idx = base + lane; float s = -INFINITY;
        if (idx < nk) { const bf16* kp = idx < nband ? Kx + (size_t)(b * SEQ + lo + idx) * 128 + kvh * 64 : KC + (size_t)(b * LC + idx - nband) * 128 + kvh * 64;
            s = 0.f; for (int d = 0; d < 64; ++d) s += qs[d] * bflo((unsigned)kp[d]); sc[idx] = s; }
        mx = fmaxf(mx, s); }
#pragma unroll
    for (int o2 = 1; o2 < 64; o2 <<= 1) mx = fmaxf(mx, __shfl_xor(mx, o2));
    __syncthreads();
    float l = 0.f, acc = 0.f;
    for (int idx = 0; idx < nk; ++idx) { const float p = __builtin_amdgcn_exp2f(sc[idx] - mx); l += p;
        const bf16* vp = idx < nband ? Vx + (size_t)(b * SEQ + lo + idx) * 128 + kvh * 64 : VC + (size_t)(b * LC + idx - nband) * 128 + kvh * 64;
        acc += p * bflo((unsigned)vp[lane]); }
    l += __builtin_amdgcn_exp2f(F.in[12][h] * LOG2E - mx);
    const float ov = acc / l; const float ss = wave_sum(ov * ov);
    if (lane == 0) xs[h] = ss;
    __syncthreads();
    float tot = 0.f;
    for (int w = 0; w < 8; ++w) tot += xs[w];
    const float rstd = 1.0f / sqrtf(tot * (1.0f / 512.0f) + EPS);
    O[(size_t)tok * DM + h * 64 + lane] = (bf16)f2bf(ov * rstd * F.in[17][h * 64 + lane]);
    __syncthreads();
}
__device__ __forceinline__ void naive_sgu_unit(Frame& F, int b, int ch) {
    const bf16* GV = (const bf16*)(F.ws + WS_GV); const bf16* U = (const bf16*)(F.ws + WS_U); bf16* O = (bf16*)(F.ws + WS_O);
    const float* ln_g = F.in[13]; const float* ln_b = F.in[14]; const float* sw = F.in[15]; const float* sgub = F.in[16]; const float* g_sgu = F.in[18];
    const int lane = F.lane, wid = F.wave, tid = F.tid, r0 = b * SEQ + ch * 128;
    LAS float* vl = (LAS float*)F.lds;
    LAS float* xs = (LAS float*)(F.lds + L_XCH);
    LAS float* st = xs + 16;
    for (int jj = 0; jj < 16; ++jj) { const int j = wid * 16 + jj; float x[8]; float s = 0.f;
#pragma unroll
        for (int q = 0; q < 8; ++q) { x[q] = bflo((unsigned)GV[(size_t)(r0 + j) * 512 + lane * 8 + q]); s += x[q]; }
        const float mean = wave_sum(s) * (1.0f / 512.0f); float s2 = 0.f;
#pragma unroll
        for (int q = 0; q < 8; ++q) { const float d = x[q] - mean; s2 += d * d; }
        const float rstd = 1.0f / sqrtf(wave_sum(s2) * (1.0f / 512.0f) + EPS);
        if (lane == 0) { st[2 * j] = mean; st[2 * j + 1] = rstd; } }
    __syncthreads();
    const int c = tid, h = c >> 6;
    for (int i = 0; i < 128; ++i) {
        float m = 0.f;
        for (int j = 0; j < 128; ++j) { const float gv = bflo((unsigned)GV[(size_t)(r0 + j) * 512 + c]); const float y = (gv - st[2 * j]) * st[2 * j + 1] * ln_g[c] + ln_b[c]; m += sw[(size_t)(h * 128 + i) * 128 + j] * y; }
        const float v = (m + sgub[h * 128 + i]) * bflo((unsigned)U[(size_t)(r0 + i) * 512 + c]);
        const float ss = wave_sum(v * v);
        __syncthreads();
        if (lane == 0) xs[wid] = ss;
        __syncthreads();
        float tot = 0.f;
        for (int w = 0; w < 8; ++w) tot += xs[w];
        const float rstd = 1.0f / sqrtf(tot * (1.0f / 512.0f) + EPS);
        O[(size_t)(r0 + i) * DM + 512 + c] = (bf16)f2bf(v * rstd * g_sgu[c]);
    }
    __syncthreads();
}


constexpr int CW_FLAGS = 32768;
__device__ __forceinline__ double dcos_red(double a) { const double tp = 6.283185307179586; a -= tp * floor(a / tp + 0.5); double t = 1.0, s = 1.0; for (int i = 1; i < 16; ++i) { t *= -a * a / ((2.0 * i - 1.0) * (2.0 * i)); s += t; } return s; }
__device__ __forceinline__ double dsin_red(double a) { const double tp = 6.283185307179586; a -= tp * floor(a / tp + 0.5); double t = a, s = a; for (int i = 1; i < 16; ++i) { t *= -a * a / ((2.0 * i) * (2.0 * i + 1.0)); s += t; } return s; }
__device__ __forceinline__ bool close_to(float got, float want, float atol, float rtol) { return fabsf(got - want) <= atol + rtol * fabsf(want); }
__device__ __forceinline__ void debug_checks(Frame& F) {
    const float* MOD = (const float*)(F.ws + WS_MOD); const bf16* H = (const bf16*)(F.ws + WS_H);
    const bf16* Q = (const bf16*)(F.ws + WS_Q); const bf16* Kx = (const bf16*)(F.ws + WS_K); const bf16* Vx = (const bf16*)(F.ws + WS_V);
    const bf16* KC = (const bf16*)(F.ws + WS_KC); const bf16* VC = (const bf16*)(F.ws + WS_VC); const bf16* U = (const bf16*)(F.ws + WS_U); const bf16* GV = (const bf16*)(F.ws + WS_GV);
    const bf16* O = (const bf16*)(F.ws + WS_O); const bf16* MIX = (const bf16*)(F.ws + WS_MIX);
    const int gw = blockIdx.x * NWAVES + F.wave, lane = F.lane;
    unsigned bad = 0u;
    for (int q = 0; q < 4; ++q) { const unsigned hsh = (unsigned)(gw * 4 + q) * 2654435761u; const int r = (hsh >> 8) % 9, n = (hsh >> 12) % NMOD;
        float a = 0.f; for (int k = lane; k < DM; k += 64) { const float v = r < 8 ? F.in[1][r * DM + k] : F.in[3][k]; a += v / (1.0f + expf(-v)) * F.in[4][(size_t)k * NMOD + n]; }
        a = wave_sum(a) + F.in[5][n];
        if (!close_to(MOD[r * NMOD + n], a, 1e-3f, 1e-3f)) bad |= 1u; }
    for (int q = 0; q < 2; ++q) { const unsigned hsh = (unsigned)(gw * 2 + q) * 2246822519u; const int m = (hsh >> 7) % (TT + TC);
        const float* xrow = m < TT ? F.in[0] + (size_t)m * DM : F.in[2] + (size_t)(m - TT) * DM; const float* md = MOD + (m < TT ? (m >> 12) : 8) * NMOD;
        float ss = 0.f; for (int k = lane; k < DM; k += 64) ss += xrow[k] * xrow[k];
        const float rstd = 1.0f / sqrtf(wave_sum(ss) / DM + EPS);
        for (int k = lane; k < DM; k += 64) { const float want = xrow[k] * rstd * F.in[6][k] * (1.0f + md[DM + k]) + md[k];
            if (!close_to(bflo((unsigned)H[(size_t)m * DM + k]), want, 2e-2f, 1e-2f)) bad |= 2u; } }
    for (int q = 0; q < 8; ++q) { const unsigned hsh = (unsigned)(gw * 8 + q) * 3266489917u; const int kind = q;
        const int row = kind == 7 ? TT + (int)((hsh >> 6) % TC) : (int)((hsh >> 6) % TT); const int d = (hsh >> 3) & 15;
        int n1, n2;
        if (kind < 2) { const int hd = (hsh >> 20) & 7; n1 = hd * 64 + (kind & 1) * 32 + d; n2 = n1 + 16; }
        else if (kind < 4) { const int hd = (hsh >> 20) & 1; n1 = 512 + hd * 64 + (kind & 1) * 32 + d; n2 = n1 + 16; }
        else if (kind == 4) { n1 = 640 + ((hsh >> 20) & 127); n2 = n1; }
        else if (kind == 5) { n1 = 768 + ((hsh >> 20) & 511); n2 = n1; }
        else if (kind == 6) { n1 = 1280 + ((hsh >> 20) & 511); n2 = n1; }
        else { n1 = 512 + ((hsh >> 20) & 127); n2 = n1 + 128; }
        float a1 = 0.f, a2 = 0.f;
        for (int k = lane; k < DM; k += 64) { const float hv = bflo((unsigned)H[(size_t)row * DM + k]); a1 += hv * F.in[10][(size_t)k * NIN + n1]; a2 += hv * F.in[10][(size_t)k * NIN + n2]; }
        a1 = wave_sum(a1) + F.in[11][n1]; a2 = wave_sum(a2) + F.in[11][n2];
        if (kind < 4) { const int t = row & (SEQ - 1); const int pos = (kind & 1) ? (t & 63) : (t >> 6);
            const double ang = (double)pos * pow(10000.0, -(double)d / 16.0); const float cs = (float)dcos_red(ang), sn = (float)dsin_red(ang);
            float w1 = a1 * cs - a2 * sn, w2 = a2 * cs + a1 * sn; if (kind < 2) { w1 *= QSCALE; w2 *= QSCALE; }
            const float g1 = kind < 2 ? bflo((unsigned)Q[(size_t)row * 512 + n1]) : bflo((unsigned)Kx[(size_t)row * 128 + n1 - 512]);
            const float g2 = kind < 2 ? bflo((unsigned)Q[(size_t)row * 512 + n2]) : bflo((unsigned)Kx[(size_t)row * 128 + n2 - 512]);
            if (!close_to(g1, w1, 3e-2f, 3e-2f) || !close_to(g2, w2, 3e-2f, 3e-2f)) bad |= (kind < 2 ? 4u : 8u); }
        else if (kind == 4) { if (!close_to(bflo((unsigned)Vx[(size_t)row * 128 + n1 - 640]), a1, 3e-2f, 3e-2f)) bad |= 16u; }
        else if (kind == 5 || kind == 6) { const float u0 = 0.7978845608f * (a1 + 0.044715f * a1 * a1 * a1); const float want = 0.5f * a1 * (1.0f + tanhf(u0));
            const float got = kind == 5 ? bflo((unsigned)U[(size_t)row * 512 + n1 - 768]) : bflo((unsigned)GV[(size_t)row * 512 + n1 - 1280]);
            if (!close_to(got, want, 3e-2f, 3e-2f)) bad |= 32u; }
        else { const float g1 = bflo((unsigned)KC[(size_t)(row - TT) * 128 + n1 - 512]), g2 = bflo((unsigned)VC[(size_t)(row - TT) * 128 + n1 - 512]);
            if (!close_to(g1, a1, 3e-2f, 3e-2f) || !close_to(g2, a2, 3e-2f, 3e-2f)) bad |= 64u; }
    }
    for (int q = 0; q < 2; ++q) { const unsigned hsh = (unsigned)(gw * 2 + q) * 668265263u; const int row = (hsh >> 6) % TT, n = (hsh >> 22) & 1023;
        float a = 0.f; for (int k = lane; k < DM; k += 64) a += bflo((unsigned)O[(size_t)row * DM + k]) * F.in[19][(size_t)k * DM + n];
        a = wave_sum(a) + F.in[20][n];
        if (!close_to(bflo((unsigned)MIX[(size_t)row * DM + n]), a, 5e-2f, 3e-2f)) bad |= 128u; }
    if (bad && lane == 0) atomicOr((unsigned*)(F.ctl + CW_FLAGS), bad);
}

__device__ __forceinline__ void p5_rows(Frame& F) {
    const float* MOD = (const float*)(F.ws + WS_MOD); const bf16* MIX = (const bf16*)(F.ws + WS_MIX); bf16* H2 = (bf16*)(F.ws + WS_H2);
    float* GATES = (float*)(F.ws + WS_GATES); int* ROWDST = (int*)(F.ws + WS_ROWDST);
    const float* g_post = F.in[7]; const float* g_pre = F.in[8]; const float* w_router = F.in[21]; const float* b_router = F.in[22];
    const int lane = F.lane, wid = F.wave, tid = F.tid;
    LAS float* wl = (LAS float*)F.lds;
    LAS int* lcount = (LAS int*)(F.lds + L_SEL); LAS int* lbase = lcount + 32; LAS int* sel_e = lcount + 64; LAS int* sel_slot = lcount + 64 + 512;
    for (int q = tid; q < 8192; q += NWAVES * 64) { const int k = q >> 3, ec = q & 7; const f32x4 v = *(const f32x4*)(w_router + k * 32 + 4 * ec);
        const int l = (k & 255) >> 2, j = k >> 8, i4 = k & 3; *(LAS f32x4*)(wl + (((j * 4 + i4) * 8 + ec) * 64 + l) * 4) = v; }
    if (tid < 32) lcount[tid] = 0;
    __syncthreads();
    for (int chunk = blockIdx.x; chunk < TT / 128; chunk += F.G) {
        for (int tt = 0; tt < 16; ++tt) {
            const int tokl = wid * 16 + tt, tok = chunk * 128 + tokl, bb = tok >> 12;
            const float* md = MOD + bb * NMOD;
            const GAS f32x4* xr = (const GAS f32x4*)(F.in[0] + (size_t)tok * DM) + lane;
            const GAS v2u* mr = (const GAS v2u*)(MIX + (size_t)tok * DM) + lane;
            f32x4 xv[4], mv[4]; float s = 0.f;
#pragma unroll
            for (int j = 0; j < 4; ++j) { xv[j] = xr[64 * j]; const v2u m2 = mr[64 * j]; mv[j] = (f32x4){bflo(m2.x), bfhi(m2.x), bflo(m2.y), bfhi(m2.y)};
                s += (mv[j].x * mv[j].x + mv[j].y * mv[j].y) + (mv[j].z * mv[j].z + mv[j].w * mv[j].w); }
            const float rstd1 = 1.0f / sqrtf(wave_sum(s) * (1.0f / DM) + EPS);
            float s2 = 0.f;
            GAS f32x4* xo = (GAS f32x4*)(F.out + (size_t)tok * DM) + lane;
#pragma unroll
            for (int j = 0; j < 4; ++j) { const int col = 4 * lane + 256 * j; const f32x4 gp = *(const f32x4*)(g_post + col), gt = *(const f32x4*)(md + 2 * DM + col);
                xv[j] = xv[j] + gt * (mv[j] * rstd1 * gp); xo[64 * j] = xv[j];
                s2 += (xv[j].x * xv[j].x + xv[j].y * xv[j].y) + (xv[j].z * xv[j].z + xv[j].w * xv[j].w); }
            const float rstd2 = 1.0f / sqrtf(wave_sum(s2) * (1.0f / DM) + EPS);
            GAS v2u* ho = (GAS v2u*)(H2 + (size_t)tok * DM) + lane;
#pragma unroll
            for (int j = 0; j < 4; ++j) { const int col = 4 * lane + 256 * j; const f32x4 gp = *(const f32x4*)(g_pre + col), sh = *(const f32x4*)(md + 3 * DM + col), sc = *(const f32x4*)(md + 4 * DM + col);
                xv[j] = xv[j] * rstd2 * gp * (sc + 1.0f) + sh; v2u o; o.x = pk2(xv[j].x, xv[j].y); o.y = pk2(xv[j].z, xv[j].w); ho[64 * j] = o; }
            float a[32];
#pragma unroll
            for (int e = 0; e < 32; ++e) a[e] = 0.f;
#pragma unroll
            for (int j = 0; j < 4; ++j)
#pragma unroll
                for (int i4 = 0; i4 < 4; ++i4) { const float hv = xv[j][i4];
#pragma unroll
                    for (int ec = 0; ec < 8; ++ec) { const f32x4 w4 = *(const LAS f32x4*)(wl + (((j * 4 + i4) * 8 + ec) * 64 + lane) * 4);
                        a[4 * ec] += hv * w4[0]; a[4 * ec + 1] += hv * w4[1]; a[4 * ec + 2] += hv * w4[2]; a[4 * ec + 3] += hv * w4[3]; } }
#pragma unroll
            for (int i = 0; i < 16; ++i) { const bool up = (lane & 32) != 0; const float send = up ? a[i] : a[i + 16], keep = up ? a[i + 16] : a[i]; a[i] = keep + __shfl_xor(send, 32); }
#pragma unroll
            for (int i = 0; i < 8; ++i) { const bool up = (lane & 16) != 0; const float send = up ? a[i] : a[i + 8], keep = up ? a[i + 8] : a[i]; a[i] = keep + __shfl_xor(send, 16); }
#pragma unroll
            for (int i = 0; i < 4; ++i) { const bool up = (lane & 8) != 0; const float send = up ? a[i] : a[i + 4], keep = up ? a[i + 4] : a[i]; a[i] = keep + __shfl_xor(send, 8); }
#pragma unroll
            for (int i = 0; i < 2; ++i) { const bool up = (lane & 4) != 0; const float send = up ? a[i] : a[i + 2], keep = up ? a[i + 2] : a[i]; a[i] = keep + __shfl_xor(send, 4); }
            { const bool up = (lane & 2) != 0; const float send = up ? a[0] : a[1], keep = up ? a[1] : a[0]; a[0] = keep + __shfl_xor(send, 2); }
            float lg = a[0] + __shfl_xor(a[0], 1);
            lg += b_router[lane >> 1];
            int esel[4]; float vsel[4];
#pragma unroll
            for (int k = 0; k < 4; ++k) { float m = lg;
#pragma unroll
                for (int o2 = 2; o2 < 64; o2 <<= 1) m = fmaxf(m, __shfl_xor(m, o2));
                const unsigned long long mask = __ballot(lg == m); const int first = __ffsll((long long)mask) - 1;
                esel[k] = first >> 1; vsel[k] = m; if ((lane >> 1) == esel[k]) lg = -INFINITY; }
            float wk[4], wsum = 0.f;
#pragma unroll
            for (int k = 0; k < 4; ++k) { wk[k] = __expf(vsel[k] - vsel[0]); wsum += wk[k]; }
            if (lane < 4) { const float gk = (lane == 0 ? wk[0] : lane == 1 ? wk[1] : lane == 2 ? wk[2] : wk[3]) / wsum; const int ek = lane == 0 ? esel[0] : lane == 1 ? esel[1] : lane == 2 ? esel[2] : esel[3];
                GATES[(size_t)tok * 4 + lane] = gk;
                const int slot = __hip_atomic_fetch_add(lcount + ek, 1, __ATOMIC_RELAXED, __HIP_MEMORY_SCOPE_WORKGROUP);
                sel_e[tokl * 4 + lane] = ek; sel_slot[tokl * 4 + lane] = slot; }
        }
        __syncthreads();
        if (tid < 32) lbase[tid] = (int)__hip_atomic_fetch_add((unsigned*)(F.ctl + CW_CNT + 64 * tid), (unsigned)lcount[tid], RLX_AGENT);
        __syncthreads();
        { const int e = sel_e[tid]; ROWDST[(size_t)e * ECAP + lbase[e] + sel_slot[tid]] = (chunk * 128 + (tid >> 2)) * 4 + (tid & 3); }
        __syncthreads();
        if (tid < 32) lcount[tid] = 0;
        __syncthreads();
    }
}

__device__ __forceinline__ void moe_tables(Frame& F) {
    LAS unsigned char* tile_e = F.lds + L_TILEE; LAS int* tab = (LAS int*)(F.lds + L_CNT);
    __syncthreads();
    if (F.tid < 32) tab[F.tid] = (int)__hip_atomic_load((unsigned*)(F.ctl + CW_CNT + 64 * F.tid), RLX_AGENT);
    __syncthreads();
    if (F.tid == 0) { int acc = 0; for (int e = 0; e < 32; ++e) { tab[32 + e] = acc; acc += (tab[e] + 255) >> 8; } tab[64] = acc; tab[65] = acc < MAXTILES ? acc : MAXTILES; }
    __syncthreads();
    for (int e = F.wave; e < 32; e += NWAVES) { const int f = tab[32 + e], n = (tab[e] + 255) >> 8; for (int q = F.lane; q < n; q += 64) if (f + q < MAXTILES) tile_e[f + q] = (unsigned char)e; }
    __syncthreads();
}

__device__ __forceinline__ void p8_final(Frame& F) {
    const float* MOD = (const float*)(F.ws + WS_MOD); const bf16* Y4 = (const bf16*)(F.ws + WS_Y4); const float* GATES = (const float*)(F.ws + WS_GATES); const float* g_post = F.in[9];
    const int gw = F.vcu * NWAVES + F.wave, NGW = F.G * NWAVES, lane = F.lane;
    for (int tok = gw; tok < TT; tok += NGW) {
        const f32x4 gt = *(const f32x4*)(GATES + (size_t)tok * 4);
        const float* md = MOD + (tok >> 12) * NMOD + 5 * DM;
        f32x4 y[4]; float s = 0.f;
#pragma unroll
        for (int j = 0; j < 4; ++j) y[j] = (f32x4){0.f, 0.f, 0.f, 0.f};
#pragma unroll
        for (int k = 0; k < 4; ++k) { const GAS v2u* yr = (const GAS v2u*)(Y4 + ((size_t)tok * 4 + k) * DM) + lane; const float gk = gt[k];
#pragma unroll
            for (int j = 0; j < 4; ++j) { const v2u m2 = yr[64 * j]; y[j] = y[j] + (f32x4){bflo(m2.x), bfhi(m2.x), bflo(m2.y), bfhi(m2.y)} * gk; } }
#pragma unroll
        for (int j = 0; j < 4; ++j) s += (y[j].x * y[j].x + y[j].y * y[j].y) + (y[j].z * y[j].z + y[j].w * y[j].w);
        const float rstd = 1.0f / sqrtf(wave_sum(s) * (1.0f / DM) + EPS);
        GAS f32x4* xo = (GAS f32x4*)(F.out + (size_t)tok * DM) + lane;
#pragma unroll
        for (int j = 0; j < 4; ++j) { const int col = 4 * lane + 256 * j; const f32x4 gp = *(const f32x4*)(g_post + col), g2 = *(const f32x4*)(md + col);
            const f32x4 xm = xo[64 * j];
            if (PROBE == 1) xo[64 * j] = xm;
            else if (PROBE == 2) xo[64 * j] = *((const GAS f32x4*)(F.in[0] + (size_t)tok * DM) + lane + 64 * j);
#if CHECKS
            else if (PROBE == 3) { const unsigned fl = __hip_atomic_load((unsigned*)(F.ctl + 32768), RLX_AGENT); const float scl = 1.0f + (float)((fl >> CHECK_BIT) & 15u) * 0.125f; xo[64 * j] = (xm + g2 * (y[j] * rstd * gp)) * scl; }
#endif
            else xo[64 * j] = xm + g2 * (y[j] * rstd * gp); }
    }
}

constexpr int N_LAUNCHES = MK_N_LAUNCHES;
constexpr int PER_PHASE = 9;
struct Args { const float* in[27]; float* out; unsigned char* ws; int ph_lo, ph_hi; };
__global__ void __launch_bounds__(NWAVES * 64, 2) fwd_kernel(Args args) {
    extern __shared__ __attribute__((aligned(16))) unsigned char lds_raw[];
    Frame F;
    F.lds = (LAS unsigned char*)lds_raw;
    F.tid = threadIdx.x; F.lane = F.tid & 63; F.wave = __builtin_amdgcn_readfirstlane(F.tid >> 6);
    F.G = gridDim.x; { const int bx = blockIdx.x; F.vcu = (F.G % 8 == 0) ? (bx % 8) * (F.G / 8) + bx / 8 : bx; }
#pragma unroll
    for (int i = 0; i < 27; ++i) F.in[i] = args.in[i];
    F.out = args.out; F.ws = args.ws; F.ctl = (gu32*)(args.ws + WS_CTL);
    for (int u = F.tid; u < (LDS_BYTES - MISC_OFF) / 4; u += NWAVES * 64) ((LAS unsigned*)(F.lds + MISC_OFF))[u] = 0u;
    __syncthreads();
    XcdBarrier bar; bar.bar = (unsigned*)(F.ctl + CW_BAR); bar.x = 0; bar.st = nullptr;
    if (N_LAUNCHES != PER_PHASE) bar = xcd_barrier_post((unsigned*)(F.ctl + CW_BAR), (volatile LAS unsigned*)(F.lds + L_BARW));
#define GRID_BAR() do { if (N_LAUNCHES == PER_PHASE) { if (F.tid == 0) __hip_atomic_store(F.ctl + CW_TMO, 0xBADBA0u, RLX_AGENT); } else { xcd_barrier(bar); } } while (0)
    const int lo = args.ph_lo, hi = args.ph_hi;
#define IN(k) (lo <= (k) && (k) < hi)
#define BOTH(k) (IN(k) && IN((k) + 1))

    if (IN(0)) { p0_prologue(F); if (BOTH(0)) GRID_BAR(); }
    if (IN(1)) { p1_prenorm(F); if (BOTH(1)) GRID_BAR(); }
    if (IN(2)) {
        pg8::SchedIn S{F.G, (int)blockIdx.x};
        pg8::EpiInProj E{F.in[11], (bf16*)(F.ws + WS_Q), (bf16*)(F.ws + WS_K), (bf16*)(F.ws + WS_V), (bf16*)(F.ws + WS_KC), (bf16*)(F.ws + WS_VC), (bf16*)(F.ws + WS_U), (bf16*)(F.ws + WS_GV), (const float*)(F.ws + WS_ROPE)};
        pg8::gemm_phase<pg8::EpiInProj, pg8::SchedIn, false, true>(F.lds, (const bf16*)(F.ws + WS_H), (const bf16*)(F.ws + WS_WIN), DM, S, E);
        if (BOTH(2)) GRID_BAR();
    }
    if (IN(3)) {
#if NAIVE_ATTN
        for (int t = blockIdx.x; t < TT; t += F.G) naive_attn_token(F, t);
#else
        for (int u = F.vcu; u < NB * 128; u += F.G) attn_unit(F, u >> 7, u & 127);
#endif
#if NAIVE_SGU
        for (int u = F.vcu; u < NB * 32; u += F.G) naive_sgu_unit(F, u >> 5, u & 31);
#else
        for (int u = F.vcu; u < NB * 32; u += F.G) sgu_unit(F, u >> 5, u & 31);
#endif
        if (BOTH(3)) GRID_BAR();
    }
    if (IN(4)) {
        pg8::SchedOut S{F.G, (int)blockIdx.x};
        pg8::EpiOut E{F.in[20], (bf16*)(F.ws + WS_MIX)};
        pg8::gemm_phase<pg8::EpiOut, pg8::SchedOut, false, true>(F.lds, (const bf16*)(F.ws + WS_O), (const bf16*)(F.ws + WS_WOUT), DM, S, E);
        if (BOTH(4)) GRID_BAR();
    }
#if CHECKS
    if (IN(5)) { debug_checks(F); __syncthreads(); }
#endif
    if (IN(5)) { p5_rows(F); if (BOTH(5)) GRID_BAR(); }
    if (IN(6)) {
        moe_tables(F);
        pg8::SchedMoe<8> S{F.G, (int)blockIdx.x, F.lds + L_TILEE, (const LAS int*)(F.lds + L_CNT), (const int*)(F.ws + WS_ROWDST)};
        pg8::EpiSwiglu E{F.in[24], (bf16*)(F.ws + WS_ACT)};
        pg8::gemm_phase<pg8::EpiSwiglu, pg8::SchedMoe<8>, true, true>(F.lds, (const bf16*)(F.ws + WS_H2), (const bf16*)(F.ws + WS_WGU), DM, S, E);
        if (BOTH(6)) GRID_BAR();
    }
    if (IN(7)) {
        moe_tables(F);
        pg8::SchedMoe<4> S{F.G, (int)blockIdx.x, F.lds + L_TILEE, (const LAS int*)(F.lds + L_CNT), (const int*)(F.ws + WS_ROWDST)};
        pg8::EpiDown E{F.in[26], (bf16*)(F.ws + WS_Y4)};
        pg8::gemm_phase<pg8::EpiDown, pg8::SchedMoe<4>, false, true>(F.lds, (const bf16*)(F.ws + WS_ACT), (const bf16*)(F.ws + WS_WD), FF, S, E);
        if (BOTH(7)) GRID_BAR();
    }
    if (IN(8)) { p8_final(F); }
#undef IN
#undef BOTH
}

extern "C" void kernel_launch(void* const* d_in, const int* in_sizes, int n_in, void* d_out, int out_size, void* d_ws, size_t ws_size, hipStream_t stream) {
    static int grid = 0;
    if (grid == 0) {
        if (n_in != 27 || in_sizes[0] != TT * DM || out_size != TT * DM || ws_size < WS_END) { fprintf(stderr, "kernel_launch: unexpected problem (n_in %d, in0 %d, out %d, ws %zu); nothing launched\n", n_in, n_in > 0 ? in_sizes[0] : -1, out_size, ws_size); grid = -1; return; }
        int dev = 0, cus = 0, per_cu = 0;
        if (hipGetDevice(&dev) != hipSuccess || hipDeviceGetAttribute(&cus, hipDeviceAttributeMultiprocessorCount, dev) != hipSuccess) { grid = -1; return; }
        if (hipFuncSetAttribute((const void*)fwd_kernel, hipFuncAttributeMaxDynamicSharedMemorySize, LDS_BYTES) != hipSuccess) { fprintf(stderr, "kernel_launch: hipFuncSetAttribute failed\n"); grid = -1; return; }
        if (hipOccupancyMaxActiveBlocksPerMultiprocessor(&per_cu, (const void*)fwd_kernel, NWAVES * 64, LDS_BYTES) != hipSuccess || per_cu < 1)
            fprintf(stderr, "kernel_launch: note: occupancy query reports %d workgroups per CU\n", per_cu);
        (void)hipGetLastError();
        grid = cus;
    }
    if (grid < 0) return;
    if (hipMemsetAsync((char*)d_ws + WS_CTL, 0, CTL_ZERO_BYTES, stream) != hipSuccess) { fprintf(stderr, "kernel_launch: memset failed\n"); return; }
    Args a{};
    for (int i = 0; i < 27; ++i) a.in[i] = (const float*)d_in[i];
    a.out = (float*)d_out; a.ws = (unsigned char*)d_ws;
    for (int li = 0; li < N_LAUNCHES; ++li) {
        if (N_LAUNCHES == PER_PHASE) { a.ph_lo = li; a.ph_hi = li + 1; } else { a.ph_lo = 0; a.ph_hi = PER_PHASE; }
        hipLaunchKernelGGL(fwd_kernel, dim3(grid), dim3(NWAVES * 64), LDS_BYTES, stream, a);
        const hipError_t le = hipPeekAtLastError();
        if (le != hipSuccess) { fprintf(stderr, "kernel_launch: launch %d failed: %s\n", li, hipGetErrorName(le)); break; }
    }
}
```

```cpp
#include <hip/hip_runtime.h>
#include <cstdio>
#include <cstdint>

#ifndef MK_N_LAUNCHES
#define MK_N_LAUNCHES 1
#endif
#ifndef PROBE
#define PROBE 0
#endif
#ifndef DUP_PHASE
#define DUP_PHASE -1
#endif
#ifndef CHECKS
#define CHECKS 0
#endif
#ifndef CHECK_BIT
#define CHECK_BIT 0
#endif
#ifndef NAIVE_ATTN
#define NAIVE_ATTN 0
#endif
#ifndef NAIVE_SGU
#define NAIVE_SGU 0
#endif
#ifndef GEMM_NAIVE
#define GEMM_NAIVE 0
#endif

#define GAS __attribute__((address_space(1)))
#define LAS __attribute__((address_space(3)))
typedef unsigned short bf16;
typedef unsigned v4u __attribute__((ext_vector_type(4)));
typedef unsigned v2u __attribute__((ext_vector_type(2)));
typedef float f32x4 __attribute__((ext_vector_type(4)));
typedef float f32x2 __attribute__((ext_vector_type(2)));
typedef float f32x16 __attribute__((ext_vector_type(16)));
typedef short bf16x8 __attribute__((ext_vector_type(8)));
typedef short s16x4 __attribute__((ext_vector_type(4)));
typedef int v4i_t __attribute__((ext_vector_type(4)));
typedef int v8i_t __attribute__((ext_vector_type(8)));
typedef GAS unsigned gu32;

constexpr int NB = 8, SEQ = 4096, DM = 1024, TT = NB * SEQ;
constexpr int LC = 256, TC = NB * LC;
constexpr int NIN = 1792, NE = 32, FF = 1024, NMOD = 6 * DM;
constexpr int ECAP = 32768;
constexpr int MAXTILES = 544;
constexpr float EPS = 1e-6f;
constexpr float LOG2E = 1.4426950408889634f;
constexpr float QSCALE = 0.125f * LOG2E;
constexpr float H2_SCALE = 8.0f, W_SCALE = 32.0f, ACT_SCALE = 4.0f;
constexpr float DQ1 = 1.0f / (H2_SCALE * W_SCALE), DQ2 = 1.0f / (ACT_SCALE * W_SCALE);

constexpr size_t MiB = 1u << 20;
constexpr size_t WS_CTL = 0, CTL_ZERO_BYTES = 1 * MiB;
constexpr size_t WS_MOD = 1 * MiB;
constexpr size_t WS_ROPE = 1 * MiB + 256 * 1024;
constexpr size_t WS_SGUW = 1 * MiB + 512 * 1024;
constexpr size_t WS_WIN = 2 * MiB;
constexpr size_t WS_WOUT = 6 * MiB;
constexpr size_t WS_WGU = 8 * MiB;
constexpr size_t WS_WD = 136 * MiB;
constexpr size_t WS_GATES = 200 * MiB;
constexpr size_t WS_ROWDST = 201 * MiB;
constexpr size_t WS_H2 = 206 * MiB;
constexpr size_t WS_Y4 = 270 * MiB;
constexpr size_t WS_H = 526 * MiB;
constexpr size_t WS_Q = 594 * MiB;
constexpr size_t WS_K = 626 * MiB;
constexpr size_t WS_V = 634 * MiB;
constexpr size_t WS_KC = 642 * MiB;
constexpr size_t WS_VC = 642 * MiB + 512 * 1024;
constexpr size_t WS_U = 643 * MiB;
constexpr size_t WS_GV = 675 * MiB;
constexpr size_t WS_O = 707 * MiB;
constexpr size_t WS_MIX = 771 * MiB;
constexpr size_t WS_ACT = 526 * MiB;
constexpr size_t WS_END = 835 * MiB;
static_assert(WS_ACT + (size_t)MAXTILES * 256 * FF * 2 <= WS_END, "act overlay");
static_assert(WS_H + (size_t)(TT + TC) * DM * 2 <= WS_Q, "h");

constexpr int CW_TMO = 0;
constexpr int CW_BAR = 4096;
constexpr int CW_CNT = 16384;

constexpr int RING_BYTES = 131072;
constexpr int MISC_OFF = RING_BYTES;
constexpr int LDS_BYTES = 147456;
constexpr int L_BARW = MISC_OFF + 32;
constexpr int L_XCH = MISC_OFF + 1024;
constexpr int L_TILEE = MISC_OFF + 6144;
constexpr int L_CNT = MISC_OFF + 7168;
constexpr int L_SEL = MISC_OFF + 8192;

#define RLX_AGENT __ATOMIC_RELAXED, __HIP_MEMORY_SCOPE_AGENT
#define LDS_WAIT() asm volatile("s_waitcnt lgkmcnt(0)" ::: "memory")
#define VM_WAIT() asm volatile("s_waitcnt vmcnt(0)" ::: "memory")
__device__ __forceinline__ unsigned f2bf(float f) { unsigned u = __builtin_bit_cast(unsigned, f); return (u + 0x7fffu + ((u >> 16) & 1u)) >> 16; }
__device__ __forceinline__ unsigned pk2(float lo, float hi) { return f2bf(lo) | (f2bf(hi) << 16); }
__device__ __forceinline__ unsigned cvt_pk_bf16(float lo, float hi) { unsigned r; asm volatile("v_cvt_pk_bf16_f32 %0, %1, %2" : "=v"(r) : "v"(lo), "v"(hi)); return r; }
__device__ __forceinline__ float clamp448(float v) { return __builtin_amdgcn_fmed3f(v, -448.0f, 448.0f); }
__device__ __forceinline__ unsigned pk4_fp8(float a, float b, float c, float d) {
    int r = __builtin_amdgcn_cvt_pk_fp8_f32(clamp448(a), clamp448(b), 0, false); r = __builtin_amdgcn_cvt_pk_fp8_f32(clamp448(c), clamp448(d), r, true); return (unsigned)r; }
__device__ __forceinline__ float bflo(unsigned u) { return __builtin_bit_cast(float, u << 16); }
__device__ __forceinline__ float bfhi(unsigned u) { return __builtin_bit_cast(float, u & 0xffff0000u); }
__device__ __forceinline__ float wave_sum(float v) {
#pragma unroll
    for (int o = 1; o < 64; o <<= 1) v += __shfl_xor(v, o);
    return v;
}
__device__ __forceinline__ float gelu_tanh(float x) {
    const float u = 0.7978845608028654f * (x + 0.044715f * x * x * x);
    return x * __builtin_amdgcn_rcpf(1.0f + __builtin_amdgcn_exp2f(-2.0f * LOG2E * u));
}

#define XB_TMO      128
#define XB_XCNT(j)  (256  + 64 * (j))
#define XB_XSUB(j)  (1280 + 64 * (j))
#define XB_XGEN(j)  (2304 + 64 * (j))
#define XB_TOP      3328
#define XB_TOPGEN   3392
#define XCD_BAR_WORDS 3456
#define XB_SPIN_CAP (1u << 18)
__device__ __forceinline__ unsigned xb_ld(unsigned* p)              { return __hip_atomic_load(p, __ATOMIC_RELAXED, __HIP_MEMORY_SCOPE_AGENT); }
__device__ __forceinline__ unsigned xb_add(unsigned* p, unsigned v) { return __hip_atomic_fetch_add(p, v, __ATOMIC_RELAXED, __HIP_MEMORY_SCOPE_AGENT); }
__device__ __forceinline__ unsigned xb_xcc_id() { return (unsigned)__builtin_amdgcn_s_getreg((3 << 11) | 20) & 0xFu; }
#define XB_SPIN(cond, bar) do { unsigned _sp = 0; while (cond) { __builtin_amdgcn_s_sleep(1); \
    if ((++_sp & 255u) == 0u) { if (xb_ld(&(bar)[XB_TMO])) break; if (_sp > XB_SPIN_CAP) { atomicAdd(&(bar)[XB_TMO], 1u); break; } } } } while (0)
struct XcdBarrier { unsigned* bar; unsigned x; volatile LAS unsigned* st; };
__device__ __forceinline__ XcdBarrier xcd_barrier_post(unsigned* bar, volatile LAS unsigned* st) {
    XcdBarrier b; b.bar = bar; b.x = xb_xcc_id(); b.st = st;
    if (threadIdx.x == 0) (void)xb_add(&bar[XB_XCNT(b.x)], 1u);
    return b;
}
__device__ __forceinline__ void xcd_barrier_complete(unsigned* bar, unsigned x, unsigned& nloc, unsigned& nx) {
    const unsigned G = gridDim.x * gridDim.y * gridDim.z;
    unsigned sum, cnt, mine, sp = 0u;
    for (;;) {
        sum = 0u; cnt = 0u; mine = 0u;
#pragma unroll
        for (unsigned j = 0; j < 16; ++j) { const unsigned c = xb_ld(&bar[XB_XCNT(j)]); sum += c; cnt += (c > 0u) ? 1u : 0u; mine = (j == x) ? c : mine; }
        if (sum == G) break;
        __builtin_amdgcn_s_sleep(1);
        if ((++sp & 255u) == 0u) { if (xb_ld(&bar[XB_TMO])) break; if (sp > XB_SPIN_CAP) { atomicAdd(&bar[XB_TMO], 1u); break; } }
    }
    nloc = mine > 0u ? mine : 1u; nx = cnt > 0u ? cnt : 1u;
}
__device__ __forceinline__ void xcd_barrier(const XcdBarrier& b) {
    asm volatile("s_waitcnt vmcnt(0)" ::: "memory");
    __syncthreads();
    if (threadIdx.x == 0) {
        unsigned* bar = b.bar;
        __builtin_amdgcn_s_waitcnt(0);
        unsigned nloc = b.st[0], nx = b.st[1];
        if (nloc == 0u) { xcd_barrier_complete(bar, b.x, nloc, nx); b.st[0] = nloc; b.st[1] = nx; }
        const unsigned old = xb_add(&bar[XB_XSUB(b.x)], 1u);
        const unsigned gen = old / nloc;
        if (old + 1u == (gen + 1u) * nloc) {
            __builtin_amdgcn_fence(__ATOMIC_RELEASE, "agent");
            asm volatile("s_waitcnt vmcnt(0)" ::: "memory");
            const unsigned og = xb_add(&bar[XB_TOP], 1u);
            const unsigned tg = og / nx;
            if (og + 1u == (tg + 1u) * nx) xb_add(&bar[XB_TOPGEN], 1u);
            else XB_SPIN(xb_ld(&bar[XB_TOPGEN]) == tg, bar);
            __builtin_amdgcn_fence(__ATOMIC_ACQUIRE, "agent");
            xb_add(&bar[XB_XGEN(b.x)], 1u);
            asm volatile("s_waitcnt vmcnt(0)" ::: "memory");
        } else {
            XB_SPIN(xb_ld(&bar[XB_XGEN(b.x)]) == gen, bar);
            __builtin_amdgcn_fence(__ATOMIC_ACQUIRE, "agent");
            asm volatile("s_waitcnt vmcnt(0)" ::: "memory");
        }
    }
    __syncthreads();
}

namespace pg8 {
constexpr int BM = 256, BK = 64, HALF = 128, HTB = HALF * BK * 2, STAGE_BYTES = 8 * HTB, NXCD = 8, WGM = 8;
__host__ __device__ __forceinline__ int lds_byte(int r, int c) { const int st = (r >> 4) * 2 + (c >> 5), rr = r & 15, cc = c & 31, ob = rr * 64 + cc * 2; return st * 1024 + (ob ^ (((ob >> 9) & 1) << 5)); }
__host__ __device__ __forceinline__ void stage_rc(int b, int& R, int& C) { const int st = b / 1024, sb = b % 1024, swz = sb ^ (((sb >> 9) & 1) << 5); R = (st >> 1) * 16 + swz / 64; C = (st & 1) * 32 + (swz % 64) / 2; }
__host__ __device__ __forceinline__ int perm32(int rho) { const int n = rho >> 4, i = rho & 15; return 8 * (i >> 2) + 4 * n + (i & 3); }

struct Unit { int pm, pn; int arow; size_t boff; int e, lt, nvalid; const int* gidx; };

__device__ __forceinline__ const char* uptr(const char* p) { const unsigned long long v = (unsigned long long)p;
    const unsigned lo = __builtin_amdgcn_readfirstlane((unsigned)v), hi = __builtin_amdgcn_readfirstlane((unsigned)(v >> 32)); return (const char*)(((unsigned long long)hi << 32) | lo); }
__device__ __forceinline__ void tile_order(int L, int nM, int nN, int& pm, int& pn) {
    const int nwg = nM * nN;
    int wgid = L; { const int q = nwg / NXCD, r = nwg % NXCD, xcd = wgid % NXCD, off = wgid / NXCD; wgid = (xcd < r ? xcd * (q + 1) : r * (q + 1) + (xcd - r) * q) + off; }
    const int nig = WGM * nN, gid = wgid / nig, fm = gid * WGM, gsz = (nM - fm) < WGM ? (nM - fm) : WGM;
    pm = fm + ((wgid % nig) % gsz); pn = (wgid % nig) / gsz;
}

#if !GEMM_NAIVE
template <class Epi, class Sched, int AMODE  , bool ALIGN_EPI, bool FP8 = false>
__device__ __forceinline__ void gemm_phase(LAS unsigned char* lds, const void* A, const void* Bt, const int K, const Sched& S, const Epi& E) {
    const int tid = threadIdx.x, wid = __builtin_amdgcn_readfirstlane(tid >> 6), lane = tid & 63, wr = wid >> 2, wc = wid & 3, fr = lane & 15, fq = lane >> 4;
    constexpr bool GATHER = AMODE != 0;
    const int rowb = K * (FP8 ? 1 : 2);
    const int nt = rowb / 128;
    unsigned voffA[2][2], voffB[2]; int Rr[2], Cc[2];
#pragma unroll
    for (int i = 0; i < 2; ++i) { int R, C; stage_rc(tid * 16 + i * 8192, R, C); Rr[i] = R; Cc[i] = C; const int Rb = Epi::PERM ? ((R & ~31) + perm32(R & 31)) : R;
        voffB[i] = (unsigned)(Rb * rowb + C * 2);
        voffA[0][i] = (unsigned)(R * rowb + C * 2); voffA[1][i] = (unsigned)((R + HALF) * rowb + C * 2); }
    const size_t kstep = (size_t)128;
    const size_t hstepB = (size_t)HALF * rowb;
    const unsigned ldsw = (unsigned)wid * 1024u;
    const int aoff = lds_byte(wr * 64 + fr, fq * 8), boff = lds_byte(wc * 32 + fr, fq * 8);
#define PG8_SA(b, h) (((b) * 2 + (h)) * HTB)
#define PG8_SB(b, h) ((4 + (b) * 2 + (h)) * HTB)
#define PG8_STAGE_A(bufoff, kb, h) do { _Pragma("unroll") for (int _i = 0; _i < 2; ++_i) \
        __builtin_amdgcn_global_load_lds((const unsigned*)((const char*)(kb) + (GATHER ? (size_t)0 : (size_t)(h) * hstepB) + voffA[GATHER ? (h) : 0][_i]), (LAS unsigned*)(lds + (bufoff) + ldsw + _i * 8192), 16, 0, 0); } while (0)
#define PG8_STAGE_B(bufoff, kb, h) do { _Pragma("unroll") for (int _i = 0; _i < 2; ++_i) \
        __builtin_amdgcn_global_load_lds((const unsigned*)((const char*)(kb) + (size_t)(h) * hstepB + voffB[_i]), (LAS unsigned*)(lds + (bufoff) + ldsw + _i * 8192), 16, 0, 0); } while (0)
#define PG8_LDA(dst, b, h) do { _Pragma("unroll") for (int m = 0; m < 4; ++m) dst[m] = PG8_CAT(*(const LAS v4i_t*)(lds + PG8_SA(b, h) + aoff + m * 2048), *(const LAS v4i_t*)(lds + PG8_SA(b, h) + aoff + m * 2048 + 1024)); } while (0)
#define PG8_LDB(dst, b, h) do { _Pragma("unroll") for (int n = 0; n < 2; ++n) dst[n] = PG8_CAT(*(const LAS v4i_t*)(lds + PG8_SB(b, h) + boff + n * 2048), *(const LAS v4i_t*)(lds + PG8_SB(b, h) + boff + n * 2048 + 1024)); } while (0)
#define PG8_MMA(ai, bj, At, Bt_) do { __builtin_amdgcn_s_setprio(1); if constexpr (FP8) { _Pragma("unroll") for (int m = 0; m < 4; ++m) _Pragma("unroll") for (int n = 0; n < 2; ++n) \
        acc[ai][bj][m][n] = __builtin_amdgcn_mfma_scale_f32_16x16x128_f8f6f4(Bt_[n], At[m], acc[ai][bj][m][n], 0, 0, 0, 0, 0, 0); } \
      else { _Pragma("unroll") for (int m = 0; m < 4; ++m) _Pragma("unroll") for (int n = 0; n < 2; ++n) { \
        acc[ai][bj][m][n] = __builtin_amdgcn_mfma_f32_16x16x32_bf16(PG8_LO(Bt_[n]), PG8_LO(At[m]), acc[ai][bj][m][n], 0, 0, 0); \
        acc[ai][bj][m][n] = __builtin_amdgcn_mfma_f32_16x16x32_bf16(PG8_HI(Bt_[n]), PG8_HI(At[m]), acc[ai][bj][m][n], 0, 0, 0); } } __builtin_amdgcn_s_setprio(0); } while (0)
#define PG8_LO(x) __builtin_bit_cast(bf16x8, __builtin_shufflevector(x, x, 0, 1, 2, 3))
#define PG8_HI(x) __builtin_bit_cast(bf16x8, __builtin_shufflevector(x, x, 4, 5, 6, 7))
#define PG8_CAT(x, y) __builtin_shufflevector(x, y, 0, 1, 2, 3, 4, 5, 6, 7)
#define PG8_WAIT_V(n) asm volatile("s_waitcnt vmcnt(" #n ")" ::: "memory")
#define PG8_WAIT_L(n) asm volatile("s_waitcnt lgkmcnt(" #n ")" ::: "memory")
#define PG8_BAR __builtin_amdgcn_s_barrier()
#define PG8_SCHED __builtin_amdgcn_sched_barrier(0)
#define PG8_GIDX(u, dst) do { _Pragma("unroll") for (int _h = 0; _h < 2; ++_h) _Pragma("unroll") for (int _i = 0; _i < 2; ++_i) { const int _row = _h * HALF + Rr[_i]; \
        int _tok; if constexpr (AMODE == 1) _tok = (_row < (u).nvalid) ? ((u).gidx[_row] >> 2) : 0; else _tok = (u).arow + _row; dst[_h][_i] = (unsigned)(_tok * rowb + Cc[_i] * 2); } } while (0)
    Unit cur, nxt; int ui = 0;
    if (!S.next(0, cur)) return;
    f32x4 acc[2][2][4][2];
#pragma unroll
    for (int a = 0; a < 2; ++a)
#pragma unroll
        for (int b = 0; b < 2; ++b)
#pragma unroll
            for (int m = 0; m < 4; ++m)
#pragma unroll
                for (int n = 0; n < 2; ++n) acc[a][b][m][n] = (f32x4){0.f, 0.f, 0.f, 0.f};
    v8i_t At[4], B0[2], B1[2];
    unsigned voffN[2][2] = {{0u, 0u}, {0u, 0u}};
    if constexpr (GATHER) { PG8_GIDX(cur, voffA); }
    const char* cA = uptr(GATHER ? (const char*)A : (const char*)A + (size_t)cur.arow * rowb); const char* cB = uptr((const char*)Bt + cur.boff);
    PG8_STAGE_B(PG8_SB(0, 0), cB, 0); PG8_STAGE_B(PG8_SB(0, 1), cB, 1); PG8_STAGE_A(PG8_SA(0, 0), cA, 0); PG8_STAGE_A(PG8_SA(0, 1), cA, 1);
    if (wr == 1) PG8_BAR;
    PG8_WAIT_V(2); PG8_BAR;
    PG8_STAGE_B(PG8_SB(1, 0), cB + kstep, 0); PG8_STAGE_A(PG8_SA(1, 0), cA + kstep, 0); PG8_STAGE_B(PG8_SB(1, 1), cB + kstep, 1);
    PG8_WAIT_V(6); PG8_BAR;
    for (;;) {
        const bool has_next = S.next(ui + 1, nxt);
        if constexpr (GATHER) { if (has_next) { PG8_GIDX(nxt, voffN); } }
        const char* nA = uptr(has_next ? (GATHER ? (const char*)A : (const char*)A + (size_t)nxt.arow * rowb) : cA); const char* nB = uptr(has_next ? (const char*)Bt + nxt.boff : cB);
#pragma unroll 1
        for (int t = 0; t < nt; t += 2) {
            const bool last = (t == nt - 2);
            const char* a1 = cA + (size_t)(t + 1) * kstep;
            const char* a2 = last ? nA : cA + (size_t)(t + 2) * kstep; const char* b2 = last ? nB : cB + (size_t)(t + 2) * kstep;
            const char* a3 = a2 + kstep; const char* b3 = b2 + kstep;
            PG8_LDB(B0, 0, 0); PG8_LDB(B1, 0, 1); PG8_SCHED; PG8_LDA(At, 0, 0); PG8_STAGE_A(PG8_SA(1, 1), a1, 1);
            if constexpr (GATHER) { if (last && has_next) {
#pragma unroll
                for (int h = 0; h < 2; ++h)
#pragma unroll
                    for (int i = 0; i < 2; ++i) voffA[h][i] = voffN[h][i]; } }
            PG8_WAIT_V(8); PG8_WAIT_L(0); PG8_BAR; PG8_MMA(0, 0, At, B0); PG8_MMA(0, 1, At, B1); PG8_BAR; PG8_SCHED;
            PG8_LDA(At, 0, 1); PG8_STAGE_B(PG8_SB(0, 0), b2, 0); PG8_STAGE_B(PG8_SB(0, 1), b2, 1); PG8_STAGE_A(PG8_SA(0, 0), a2, 0);
            PG8_WAIT_V(8); PG8_WAIT_L(0); PG8_BAR; PG8_MMA(1, 0, At, B0); PG8_MMA(1, 1, At, B1); PG8_BAR; PG8_SCHED;
            PG8_LDB(B0, 1, 0); PG8_LDB(B1, 1, 1); PG8_SCHED; PG8_LDA(At, 1, 0); PG8_STAGE_A(PG8_SA(0, 1), a2, 1);
            PG8_WAIT_V(8); PG8_WAIT_L(0); PG8_BAR; PG8_MMA(0, 0, At, B0); PG8_MMA(0, 1, At, B1); PG8_BAR; PG8_SCHED;
            PG8_LDA(At, 1, 1); PG8_STAGE_B(PG8_SB(1, 0), b3, 0); PG8_STAGE_B(PG8_SB(1, 1), b3, 1); PG8_STAGE_A(PG8_SA(1, 0), a3, 0);
            PG8_WAIT_V(8); PG8_WAIT_L(0); PG8_BAR; PG8_MMA(1, 0, At, B0); PG8_MMA(1, 1, At, B1); PG8_BAR; PG8_SCHED;
        }
        if constexpr (ALIGN_EPI) { if (wr == 0) PG8_BAR; }
        E(acc, cur, wr, wc, fr, fq);
        if (!has_next) break;
#pragma unroll
        for (int a = 0; a < 2; ++a)
#pragma unroll
            for (int b = 0; b < 2; ++b)
#pragma unroll
                for (int m = 0; m < 4; ++m)
#pragma unroll
                    for (int n = 0; n < 2; ++n) acc[a][b][m][n] = (f32x4){0.f, 0.f, 0.f, 0.f};
        cur = nxt; cA = nA; cB = nB; ++ui;
        if constexpr (ALIGN_EPI) { if (wr == 1) PG8_BAR; }
    }
    PG8_WAIT_V(0);
    if constexpr (!ALIGN_EPI) { if (wr == 0) PG8_BAR; }
    PG8_BAR;
#undef PG8_SA
#undef PG8_SB
#undef PG8_STAGE_A
#undef PG8_STAGE_B
#undef PG8_LDA
#undef PG8_LDB
#undef PG8_MMA
#undef PG8_CAT
#undef PG8_LO
#undef PG8_HI
#undef PG8_WAIT_V
#undef PG8_WAIT_L
#undef PG8_BAR
#undef PG8_SCHED
#undef PG8_GIDX
}
#else
template <class Epi, class Sched, int AMODE, bool ALIGN_EPI, bool FP8 = false>
__device__ __forceinline__ void gemm_phase(LAS unsigned char* lds, const void* A_, const void* Bt, const int K, const Sched& S, const Epi& E) {
    static_assert(!FP8, "the debug GEMM is bf16 only"); const bf16* A = (const bf16*)A_; constexpr bool GATHER = AMODE == 1;
    const int tid = threadIdx.x, wid = __builtin_amdgcn_readfirstlane(tid >> 6), lane = tid & 63, wr = wid >> 2, wc = wid & 3, fr = lane & 15, fq = lane >> 4;
    constexpr int PITCH = 66;
    LAS bf16* As = (LAS bf16*)lds; LAS bf16* Bs = (LAS bf16*)(lds + 256 * PITCH * 2);
    Unit u;
    for (int ui = 0; S.next(ui, u); ++ui) {
        f32x4 acc[2][2][4][2];
#pragma unroll
        for (int a = 0; a < 2; ++a)
#pragma unroll
            for (int b = 0; b < 2; ++b)
#pragma unroll
                for (int m = 0; m < 4; ++m)
#pragma unroll
                    for (int n = 0; n < 2; ++n) acc[a][b][m][n] = (f32x4){0.f, 0.f, 0.f, 0.f};
        for (int kt = 0; kt < K; kt += 64) {
            __syncthreads();
            for (int q = tid; q < 2048; q += 512) { const int row = q >> 3, c8 = (q & 7) * 8;
                int arow; if (GATHER) arow = (row < u.nvalid) ? (u.gidx[row] >> 2) : 0; else arow = u.arow + row;
                const v4u va = *(const v4u*)(A + (size_t)arow * K + kt + c8);
                LAS unsigned* da = (LAS unsigned*)(As + row * PITCH + c8); da[0] = va.x; da[1] = va.y; da[2] = va.z; da[3] = va.w;
                const v4u vb = *(const v4u*)((const char*)Bt + u.boff + ((size_t)row * K + kt + c8) * 2);
                LAS unsigned* db = (LAS unsigned*)(Bs + row * PITCH + c8); db[0] = vb.x; db[1] = vb.y; db[2] = vb.z; db[3] = vb.w; }
            __syncthreads();
            for (int k = 0; k < 64; ++k) {
                float av[2][4], bv[2][2][4];
#pragma unroll
                for (int ai = 0; ai < 2; ++ai)
#pragma unroll
                    for (int m = 0; m < 4; ++m) av[ai][m] = bflo((unsigned)As[(ai * 128 + wr * 64 + m * 16 + fr) * PITCH + k]);
#pragma unroll
                for (int bj = 0; bj < 2; ++bj)
#pragma unroll
                    for (int n = 0; n < 2; ++n)
#pragma unroll
                        for (int j = 0; j < 4; ++j) { const int col = bj * 128 + wc * 32 + (Epi::PERM ? (8 * fq + 4 * n + j) : (16 * n + 4 * fq + j)); bv[bj][n][j] = bflo((unsigned)Bs[col * PITCH + k]); }
#pragma unroll
                for (int ai = 0; ai < 2; ++ai)
#pragma unroll
                    for (int bj = 0; bj < 2; ++bj)
#pragma unroll
                        for (int m = 0; m < 4; ++m)
#pragma unroll
                            for (int n = 0; n < 2; ++n)
#pragma unroll
                                for (int j = 0; j < 4; ++j) acc[ai][bj][m][n][j] += av[ai][m] * bv[bj][n][j];
            }
        }
        E(acc, u, wr, wc, fr, fq);
    }
    __syncthreads();
}
#endif

struct SchedIn {
    int G, c;
    __device__ __forceinline__ bool next(int i, Unit& u) const {
        const int L = i * G + c; constexpr int NL = 128 * 7;
        if (L >= NL + 8) return false;
        if (L < NL) tile_order(L, 128, 7, u.pm, u.pn); else { u.pm = 128 + (L - NL); u.pn = 2; }
        u.arow = u.pm * 256; u.boff = (size_t)u.pn * 256 * DM * 2; u.e = 0; u.lt = 0; u.nvalid = 256; u.gidx = nullptr; return true;
    }
};
struct SchedOut {
    int G, c;
    __device__ __forceinline__ bool next(int i, Unit& u) const {
        const int L = i * G + c; if (L >= 128 * 4) return false;
        tile_order(L, 128, 4, u.pm, u.pn);
        u.arow = u.pm * 256; u.boff = (size_t)u.pn * 256 * DM * 2; u.e = 0; u.lt = 0; u.nvalid = 256; u.gidx = nullptr; return true;
    }
};
template <int NN, int ESZ> struct SchedMoe {
    int G, c; const LAS unsigned char* tile_e; const LAS int* tab; const int* rowdst;
    __device__ __forceinline__ bool next(int i, Unit& u) const {
        const int ntiles = __builtin_amdgcn_readfirstlane(tab[65]); const int L = i * G + c; if (L >= ntiles * NN) return false;
        tile_order(L, ntiles, NN, u.pm, u.pn);
        const int e = __builtin_amdgcn_readfirstlane((int)tile_e[u.pm]); u.e = e; u.lt = u.pm - __builtin_amdgcn_readfirstlane(tab[32 + e]);
        const int rem = __builtin_amdgcn_readfirstlane(tab[e]) - u.lt * 256; u.nvalid = rem < 256 ? rem : 256;
        u.gidx = rowdst + (size_t)e * ECAP + u.lt * 256;
        u.arow = u.pm * 256; u.boff = ((size_t)e * NN * 256 + (size_t)u.pn * 256) * DM * ESZ; return true;
    }
};

struct EpiInProj {
    static constexpr bool PERM = true;
    const float* bias; bf16 *Q, *Kx, *V, *KC, *VC, *U, *GV; const float* rope;
    __device__ __forceinline__ void operator()(const f32x4 (&acc)[2][2][4][2], const Unit& u, int wr, int wc, int fr, int fq) const {
        const int row0 = u.pm * BM + wr * 64 + fr, colt = wc * 32 + 8 * fq, pn = u.pn;
        f32x4 bv[2][2];
#pragma unroll
        for (int bj = 0; bj < 2; ++bj)
#pragma unroll
            for (int n = 0; n < 2; ++n) bv[bj][n] = *(const f32x4*)(bias + pn * 256 + bj * HALF + colt + 4 * n);
        if (pn <= 2) {
            const bool ctxrow = u.pm >= 128; const bool upper = (fq >> 1) != 0;
#pragma unroll
            for (int ai = 0; ai < 2; ++ai)
#pragma unroll
                for (int m = 0; m < 4; ++m) {
                    const int row = row0 + ai * HALF + m * 16; const int t = row & (SEQ - 1); const int pos = (wc & 1) ? (t & 63) : (t >> 6);
                    const f32x4 c0 = *(const f32x4*)(rope + pos * 16 + 8 * (fq & 1)), c1 = *(const f32x4*)(rope + pos * 16 + 8 * (fq & 1) + 4);
                    const f32x4 s0 = *(const f32x4*)(rope + 1024 + pos * 16 + 8 * (fq & 1)), s1 = *(const f32x4*)(rope + 1024 + pos * 16 + 8 * (fq & 1) + 4);
#pragma unroll
                    for (int bj = 0; bj < 2; ++bj) {
                        const bool dorope = (pn < 2) || (bj == 0 && !ctxrow);
                        const f32x4 vin0 = acc[ai][bj][m][0] + bv[bj][0], vin1 = acc[ai][bj][m][1] + bv[bj][1];
                        f32x4 v[2]; v[0] = vin0; v[1] = vin1;
                        if (dorope) {
                            float ro[2][4];
#pragma unroll
                            for (int n = 0; n < 2; ++n)
#pragma unroll
                                for (int j = 0; j < 4; ++j) {
                                    const float xin = n ? vin1[j] : vin0[j];
                                    const unsigned xb = __builtin_bit_cast(unsigned, xin);
                                    auto rr = __builtin_amdgcn_permlane32_swap(xb, xb, false, false);
                                    const float x1 = __builtin_bit_cast(float, (unsigned)rr[0]), x2 = __builtin_bit_cast(float, (unsigned)rr[1]);
                                    const float cs = n ? c1[j] : c0[j], sn = n ? s1[j] : s0[j];
                                    ro[n][j] = upper ? (x2 * cs + x1 * sn) : (x1 * cs - x2 * sn);
                                }
                            v[0] = (f32x4){ro[0][0], ro[0][1], ro[0][2], ro[0][3]}; v[1] = (f32x4){ro[1][0], ro[1][1], ro[1][2], ro[1][3]};
                        }
                        if (pn < 2) { v[0] = v[0] * QSCALE; v[1] = v[1] * QSCALE; }
                        v4u w; w.x = cvt_pk_bf16(v[0][0], v[0][1]); w.y = cvt_pk_bf16(v[0][2], v[0][3]); w.z = cvt_pk_bf16(v[1][0], v[1][1]); w.w = cvt_pk_bf16(v[1][2], v[1][3]);
                        bf16* dst;
                        if (pn < 2) dst = Q + (size_t)row * 512 + pn * 256 + bj * HALF + colt;
                        else if (!ctxrow) dst = (bj == 0 ? Kx : V) + (size_t)row * 128 + colt;
                        else dst = (bj == 0 ? KC : VC) + (size_t)(row - TT) * 128 + colt;
                        *(v4u*)dst = w;
                    }
                }
        } else {
            bf16* base = (pn < 5 ? U : GV) + ((pn - 3) & 1) * 256 + colt;
#pragma unroll
            for (int ai = 0; ai < 2; ++ai)
#pragma unroll
                for (int m = 0; m < 4; ++m) { const int row = row0 + ai * HALF + m * 16;
#pragma unroll
                    for (int bj = 0; bj < 2; ++bj) { f32x4 v0 = acc[ai][bj][m][0] + bv[bj][0], v1 = acc[ai][bj][m][1] + bv[bj][1];
#pragma unroll
                        for (int j = 0; j < 4; ++j) { v0[j] = gelu_tanh(v0[j]); v1[j] = gelu_tanh(v1[j]); }
                        v4u w; w.x = cvt_pk_bf16(v0[0], v0[1]); w.y = cvt_pk_bf16(v0[2], v0[3]); w.z = cvt_pk_bf16(v1[0], v1[1]); w.w = cvt_pk_bf16(v1[2], v1[3]);
                        *(v4u*)(base + (size_t)row * 512 + bj * HALF) = w; } }
        }
    }
};
struct EpiOut {
    static constexpr bool PERM = true;
    const float* bias; bf16* O;
    __device__ __forceinline__ void operator()(const f32x4 (&acc)[2][2][4][2], const Unit& u, int wr, int wc, int fr, int fq) const {
        const int row0 = u.pm * BM + wr * 64 + fr, col0 = u.pn * BM + wc * 32 + 8 * fq;
        f32x4 bv[2][2];
#pragma unroll
        for (int bj = 0; bj < 2; ++bj)
#pragma unroll
            for (int n = 0; n < 2; ++n) bv[bj][n] = *(const f32x4*)(bias + col0 + bj * HALF + 4 * n);
#pragma unroll
        for (int ai = 0; ai < 2; ++ai)
#pragma unroll
            for (int m = 0; m < 4; ++m) { bf16* rowp = O + (size_t)(row0 + ai * HALF + m * 16) * DM + col0;
#pragma unroll
                for (int bj = 0; bj < 2; ++bj) { const f32x4 v0 = acc[ai][bj][m][0] + bv[bj][0], v1 = acc[ai][bj][m][1] + bv[bj][1];
                    v4u w; w.x = cvt_pk_bf16(v0[0], v0[1]); w.y = cvt_pk_bf16(v0[2], v0[3]); w.z = cvt_pk_bf16(v1[0], v1[1]); w.w = cvt_pk_bf16(v1[2], v1[3]);
                    *(v4u*)(rowp + bj * HALF) = w; } }
    }
};
struct EpiSwiglu {
    static constexpr bool PERM = true;
    const float* bgu; unsigned char* ACT;
    __device__ __forceinline__ void operator()(const f32x4 (&acc)[2][2][4][2], const Unit& u, int wr, int wc, int fr, int fq) const {
        asm volatile("" : "+v"(fr), "+v"(fq));
        const int row0 = u.pm * BM + wr * 64 + fr, colt = u.pn * HALF + wc * 32 + 8 * fq;
        const float* bg = bgu + (size_t)u.e * 2048 + colt;
        f32x4 bgv[2], buv[2];
#pragma unroll
        for (int n = 0; n < 2; ++n) { bgv[n] = *(const f32x4*)(bg + 4 * n); buv[n] = *(const f32x4*)(bg + 1024 + 4 * n); }
#pragma unroll
        for (int ai = 0; ai < 2; ++ai)
#pragma unroll
            for (int m = 0; m < 4; ++m) { f32x4 o[2];
#pragma unroll
                for (int n = 0; n < 2; ++n) { const f32x4 g4 = acc[ai][0][m][n] * DQ1 + bgv[n], u4 = acc[ai][1][m][n] * DQ1 + buv[n];
#pragma unroll
                    for (int j = 0; j < 4; ++j) { const float g = fminf(g4[j], 7.0f), up = fminf(fmaxf(u4[j], -7.0f), 7.0f);
                        o[n][j] = ACT_SCALE * (up + 1.0f) * g * __builtin_amdgcn_rcpf(1.0f + __builtin_amdgcn_exp2f(-1.702f * LOG2E * g)); } }
                v2u w; w.x = pk4_fp8(o[0][0], o[0][1], o[0][2], o[0][3]); w.y = pk4_fp8(o[1][0], o[1][1], o[1][2], o[1][3]);
                *(v2u*)(ACT + (size_t)(row0 + ai * HALF + m * 16) * FF + colt) = w; }
    }
};
struct EpiDown {
    static constexpr bool PERM = true;
    const float* bd; bf16* Y4;
    __device__ __forceinline__ void operator()(const f32x4 (&acc)[2][2][4][2], const Unit& u, int wr, int wc, int fr, int fq) const {
        asm volatile("" : "+v"(fr), "+v"(fq));
        const int rl0 = wr * 64 + fr, col0 = u.pn * BM + wc * 32 + 8 * fq;
        const float* bp = bd + (size_t)u.e * DM + col0;
        f32x4 bv[2][2];
#pragma unroll
        for (int bj = 0; bj < 2; ++bj)
#pragma unroll
            for (int n = 0; n < 2; ++n) bv[bj][n] = *(const f32x4*)(bp + bj * HALF + 4 * n);
#pragma unroll
        for (int ai = 0; ai < 2; ++ai)
#pragma unroll
            for (int m = 0; m < 4; ++m) { const int rl = rl0 + ai * HALF + m * 16;
                if (rl < u.nvalid) { const int dst = u.gidx[rl]; bf16* rowp = Y4 + (size_t)dst * DM + col0;
#pragma unroll
                    for (int bj = 0; bj < 2; ++bj) { const f32x4 v0 = acc[ai][bj][m][0] * DQ2 + bv[bj][0], v1 = acc[ai][bj][m][1] * DQ2 + bv[bj][1];
                        v4u w; w.x = cvt_pk_bf16(v0[0], v0[1]); w.y = cvt_pk_bf16(v0[2], v0[3]); w.z = cvt_pk_bf16(v1[0], v1[1]); w.w = cvt_pk_bf16(v1[2], v1[3]);
                        *(v4u*)(rowp + bj * HALF) = w; } } }
    }
};
}

constexpr int NWAVES = 8;
struct Frame {
    LAS unsigned char* lds;
    gu32* ctl;
    int tid, lane, wave;
    int vcu, G;
    const float* in[27]; float* out; unsigned char* ws;
};

__device__ __forceinline__ void p0_transpose_item(const float* W, int K, int N, bf16* WT, int drow0, int k0, int n0, LAS float* scr, int lane) {
#pragma unroll 8
    for (int i = 0; i < 32; ++i) { const int kk = 2 * i + (lane >> 5); scr[kk * 33 + (lane & 31)] = W[(size_t)(k0 + kk) * N + n0 + (lane & 31)]; }
    LDS_WAIT(); asm volatile("" ::: "memory");
    const int c = lane & 7;
#pragma unroll
    for (int j = 0; j < 4; ++j) { const int n = (lane >> 3) + 8 * j; const LAS float* s = scr + (8 * c) * 33 + n;
        v4u o; o.x = pk2(s[0 * 33], s[1 * 33]); o.y = pk2(s[2 * 33], s[3 * 33]); o.z = pk2(s[4 * 33], s[5 * 33]); o.w = pk2(s[6 * 33], s[7 * 33]);
        *(GAS v4u*)(WT + (size_t)(drow0 + n) * K + k0 + 8 * c) = o; }
    LDS_WAIT(); asm volatile("" ::: "memory");
}
__device__ __forceinline__ void p0_transpose_item_fp8(const float* W, int K, int N, unsigned char* WT, int drow0, int k0, int n0, LAS float* scr, int lane) {
#pragma unroll 8
    for (int i = 0; i < 32; ++i) { const int kk = 2 * i + (lane >> 5); scr[kk * 33 + (lane & 31)] = W[(size_t)(k0 + kk) * N + n0 + (lane & 31)]; }
    LDS_WAIT(); asm volatile("" ::: "memory");
#pragma unroll
    for (int p = 0; p < 2; ++p) { const int ch = lane + 64 * p, n = ch >> 2, c = ch & 3; const LAS float* s = scr + (16 * c) * 33 + n;
        v4u o;
        o.x = pk4_fp8(s[0 * 33] * W_SCALE, s[1 * 33] * W_SCALE, s[2 * 33] * W_SCALE, s[3 * 33] * W_SCALE); o.y = pk4_fp8(s[4 * 33] * W_SCALE, s[5 * 33] * W_SCALE, s[6 * 33] * W_SCALE, s[7 * 33] * W_SCALE);
        o.z = pk4_fp8(s[8 * 33] * W_SCALE, s[9 * 33] * W_SCALE, s[10 * 33] * W_SCALE, s[11 * 33] * W_SCALE); o.w = pk4_fp8(s[12 * 33] * W_SCALE, s[13 * 33] * W_SCALE, s[14 * 33] * W_SCALE, s[15 * 33] * W_SCALE);
        *(GAS v4u*)(WT + (size_t)(drow0 + n) * K + k0 + 16 * c) = o; }
    LDS_WAIT(); asm volatile("" ::: "memory");
}
__device__ __forceinline__ void p0_prologue(Frame& F) {
    const float* c = F.in[1]; const float* c_ctx = F.in[3]; const float* w_ada = F.in[4]; const float* b_ada = F.in[5];
    float* MOD = (float*)(F.ws + WS_MOD);
    if ((int)blockIdx.x < NMOD / 32) {
        LAS float* sl = (LAS float*)F.lds;
        LAS float* red = (LAS float*)(F.lds + 9 * 1024 * 4);
        for (int q = F.tid; q < 9 * 1024; q += NWAVES * 64) { const float v = q < 8192 ? c[q] : c_ctx[q - 8192]; sl[q] = v / (1.0f + __expf(-v)); }
        __syncthreads();
        for (int item = blockIdx.x; item < NMOD / 32; item += F.G) {
            const int n0 = item * 32, col = F.lane & 31, kp = F.lane >> 5;
            float a[9];
#pragma unroll
            for (int r = 0; r < 9; ++r) a[r] = 0.f;
#pragma unroll 8
            for (int kk = 0; kk < 64; ++kk) { const int k = F.wave * 128 + 2 * kk + kp; const float wv = w_ada[(size_t)k * NMOD + n0 + col];
#pragma unroll
                for (int r = 0; r < 9; ++r) a[r] += sl[r * 1024 + k] * wv; }
#pragma unroll
            for (int r = 0; r < 9; ++r) { a[r] += __shfl_xor(a[r], 32); if (F.lane < 32) red[(F.wave * 9 + r) * 32 + col] = a[r]; }
            __syncthreads();
            if (F.tid < 9 * 32) { const int r = F.tid >> 5, cc = F.tid & 31; float s = b_ada[n0 + cc];
#pragma unroll
                for (int w = 0; w < 8; ++w) s += red[(w * 9 + r) * 32 + cc];
                MOD[r * NMOD + n0 + cc] = s; }
            __syncthreads();
        }
    }
    __syncthreads();
    if ((int)blockIdx.x == F.G - 1) {
        float* rope = (float*)(F.ws + WS_ROPE);
        for (int q = F.tid; q < 1024; q += NWAVES * 64) { const int pos = q >> 4, f = q & 15;
            const float inv = __builtin_amdgcn_exp2f(-(float)f * (13.287712379549449f / 16.0f));
            const float ang = (float)pos * inv; rope[q] = __cosf(ang); rope[1024 + q] = __sinf(ang); }
    }
    { const float* sw = F.in[15]; bf16* so = (bf16*)(F.ws + WS_SGUW);
      for (int q = blockIdx.x * NWAVES * 64 + F.tid; q < 8 * 128 * 128 / 4; q += F.G * NWAVES * 64) { const f32x4 v = *(const f32x4*)(sw + 4 * q); v2u o; o.x = pk2(v[0], v[1]); o.y = pk2(v[2], v[3]); *(v2u*)(so + 4 * q) = o; } }
    LAS float* scr = (LAS float*)(F.lds + F.wave * 16384);
    const int gw = F.vcu * NWAVES + F.wave, NGW = F.G * NWAVES;
    constexpr int I_IN = 16 * (NIN / 32), I_OUT = 16 * (DM / 32), I_GU = 16 * (2048 / 32), I_D = 16 * (DM / 32);
    constexpr int NITEMS = I_IN + I_OUT + NE * I_GU + NE * I_D;
    bf16* win = (bf16*)(F.ws + WS_WIN); bf16* wout = (bf16*)(F.ws + WS_WOUT); unsigned char* wgu = F.ws + WS_WGU; unsigned char* wd = F.ws + WS_WD;
    for (int it = gw; it < NITEMS; it += NGW) {
        int r = it;
        if (r < I_IN) { const int nb = NIN / 32; p0_transpose_item(F.in[10], DM, NIN, win, 32 * (r % nb), 64 * (r / nb), 32 * (r % nb), scr, F.lane); continue; } r -= I_IN;
        if (r < I_OUT) { const int nb = DM / 32; p0_transpose_item(F.in[19], DM, DM, wout, 32 * (r % nb), 64 * (r / nb), 32 * (r % nb), scr, F.lane); continue; } r -= I_OUT;
        if (r < NE * I_GU) { const int e = r / I_GU, q = r % I_GU, nb = 2048 / 32, n0 = 32 * (q % nb), k0 = 64 * (q / nb);
            const int drow = n0 < 1024 ? (n0 >> 7) * 256 + (n0 & 127) : ((n0 - 1024) >> 7) * 256 + 128 + ((n0 - 1024) & 127);
            p0_transpose_item_fp8(F.in[23] + (size_t)e * DM * 2048, DM, 2048, wgu + (size_t)e * 2048 * DM, drow, k0, n0, scr, F.lane); continue; } r -= NE * I_GU;
        { const int e = r / I_D, q = r % I_D, nb = DM / 32, n0 = 32 * (q % nb), k0 = 64 * (q / nb);
            p0_transpose_item_fp8(F.in[25] + (size_t)e * FF * DM, FF, DM, wd + (size_t)e * DM * FF, n0, k0, n0, scr, F.lane); }
    }
}

__device__ __forceinline__ void p1_prenorm(Frame& F) {
    const float* MOD = (const float*)(F.ws + WS_MOD); const float* g = F.in[6]; bf16* H = (bf16*)(F.ws + WS_H);
    const int gw = F.vcu * NWAVES + F.wave, NGW = F.G * NWAVES;
    for (int m = gw; m < TT + TC; m += NGW) {
        const float* xrow = m < TT ? F.in[0] + (size_t)m * DM : F.in[2] + (size_t)(m - TT) * DM;
        const float* md = MOD + (m < TT ? (m >> 12) : 8) * NMOD;
        const GAS f32x4* xr = (const GAS f32x4*)xrow + F.lane;
        f32x4 v[4]; float s = 0.f;
#pragma unroll
        for (int j = 0; j < 4; ++j) { v[j] = xr[64 * j]; s += (v[j].x * v[j].x + v[j].y * v[j].y) + (v[j].z * v[j].z + v[j].w * v[j].w); }
        const float rstd = 1.0f / sqrtf(wave_sum(s) * (1.0f / DM) + EPS);
        GAS v2u* o8 = (GAS v2u*)(H + (size_t)m * DM) + F.lane;
#pragma unroll
        for (int j = 0; j < 4; ++j) { const int col = 4 * F.lane + 256 * j;
            const f32x4 gg = *(const f32x4*)(g + col), sh = *(const f32x4*)(md + col), sc = *(const f32x4*)(md + DM + col);
            const f32x4 y = v[j] * rstd * gg * (sc + 1.0f) + sh;
            v2u o; o.x = pk2(y.x, y.y); o.y = pk2(y.z, y.w); o8[64 * j] = o; }
    }
}

__device__ __forceinline__ int crow(int r, int hi) { return (r & 3) + 8 * (r >> 2) + 4 * hi; }
typedef short v4i16_t __attribute__((ext_vector_type(4)));
__device__ __forceinline__ s16x4 vtr(const LAS unsigned char* p) { return __builtin_bit_cast(s16x4, __builtin_amdgcn_ds_read_tr16_b64_v4i16((LAS v4i16_t*)p)); }
__device__ __forceinline__ float swapsum(float v) { auto rr = __builtin_amdgcn_permlane32_swap(__builtin_bit_cast(unsigned, v), __builtin_bit_cast(unsigned, v), false, false); return __builtin_bit_cast(float, (unsigned)rr[0]) + __builtin_bit_cast(float, (unsigned)rr[1]); }
__device__ __forceinline__ float swapmax(float v) { auto rr = __builtin_amdgcn_permlane32_swap(__builtin_bit_cast(unsigned, v), __builtin_bit_cast(unsigned, v), false, false); return fmaxf(__builtin_bit_cast(float, (unsigned)rr[0]), __builtin_bit_cast(float, (unsigned)rr[1])); }

__device__ __forceinline__ void attn_unit(Frame& F, int b, int pb) {
    const bf16* Q = (const bf16*)(F.ws + WS_Q); const bf16* Kx = (const bf16*)(F.ws + WS_K); const bf16* Vx = (const bf16*)(F.ws + WS_V);
    const bf16* KC = (const bf16*)(F.ws + WS_KC); const bf16* VC = (const bf16*)(F.ws + WS_VC); bf16* O = (bf16*)(F.ws + WS_O);
    const float* sink = F.in[12]; const float* g_attn = F.in[17];
    const int lane = F.lane, r32 = lane & 31, hi = lane >> 5, wid = F.wave, hq = wid, kvh = wid >> 2;
    const int p0 = pb * 32, rowbase = b * SEQ;
    LAS unsigned char* lds = F.lds;
    LAS float* xch = (LAS float*)(F.lds + L_XCH);
    bf16x8 qr[4];
    { const bf16* qp = Q + (size_t)(rowbase + p0 + r32) * 512 + hq * 64 + hi * 8;
#pragma unroll
      for (int d0 = 0; d0 < 4; ++d0) qr[d0] = *(const bf16x8*)(qp + d0 * 16); }
    const int tlo = (p0 < 65) ? (p0 == 0 ? 2 : 1) : 0;
    const int thi = (p0 >= SEQ - 64) ? 2 : ((p0 >= SEQ - 128) ? 3 : 4);
    const int nb = thi - tlo + 1, ntile = nb + 4;
    v4u kreg[2], vreg[2];
#define ATT_LOAD_TILE(s_) do { const bf16 *kb_, *vb_; int krow_, vrow_; \
        if ((s_) < nb) { const int kp0_ = p0 - 128 + 64 * (tlo + (s_)); int kr_ = kp0_ + lane; kr_ = kr_ < 0 ? 0 : (kr_ > SEQ - 1 ? SEQ - 1 : kr_); \
            int vr_ = kp0_ + 16 * (wid & 3) + (lane >> 2); vr_ = vr_ < 0 ? 0 : (vr_ > SEQ - 1 ? SEQ - 1 : vr_); \
            kb_ = Kx + (size_t)rowbase * 128; vb_ = Vx + (size_t)rowbase * 128; krow_ = kr_; vrow_ = vr_; } \
        else { const int c0_ = 64 * ((s_) - nb); kb_ = KC + (size_t)b * LC * 128; vb_ = VC + (size_t)b * LC * 128; krow_ = c0_ + lane; vrow_ = c0_ + 16 * (wid & 3) + (lane >> 2); } \
        _Pragma("unroll") for (int i_ = 0; i_ < 2; ++i_) { kreg[i_] = *(const v4u*)(kb_ + (size_t)krow_ * 128 + i_ * 64 + 8 * wid); \
            vreg[i_] = *(const v4u*)(vb_ + (size_t)vrow_ * 128 + i_ * 64 + (wid >> 2) * 32 + (lane & 3) * 8); } } while (0)
#define ATT_WRITE_TILE(buf_) do { _Pragma("unroll") for (int i_ = 0; i_ < 2; ++i_) { *(LAS v4u*)(lds + (buf_) * 32768 + i_ * 8192 + wid * 1024 + lane * 16) = kreg[i_]; \
            *(LAS v4u*)(lds + (buf_) * 32768 + 16384 + i_ * 8192 + wid * 1024 + lane * 16) = vreg[i_]; } } while (0)
    ATT_LOAD_TILE(0); ATT_WRITE_TILE(0);
    float mrun = -INFINITY, lrun = 0.f; f32x16 o[2];
#pragma unroll
    for (int r = 0; r < 16; ++r) { o[0][r] = 0.f; o[1][r] = 0.f; }
    const int vlane = ((lane >> 4) & 1) * 32 + (lane & 3) * 8 + (4 * hi + ((lane & 15) >> 2)) * 64;
    for (int s = 0; s < ntile; ++s) {
        __syncthreads();
        if (s + 1 < ntile) ATT_LOAD_TILE(s + 1);
        const LAS unsigned char* Ks = lds + (s & 1) * 32768 + kvh * 8192;
        const LAS unsigned char* Vs = lds + (s & 1) * 32768 + 16384 + kvh * 8192;
        f32x16 p0v, p1v;
#pragma unroll
        for (int r = 0; r < 16; ++r) { p0v[r] = 0.f; p1v[r] = 0.f; }
        { const LAS unsigned char* kp = Ks + hi * 1024 + r32 * 16;
#pragma unroll
          for (int d0 = 0; d0 < 4; ++d0) { const bf16x8 k0 = *(const LAS bf16x8*)(kp + d0 * 2048), k1 = *(const LAS bf16x8*)(kp + d0 * 2048 + 512);
              p0v = __builtin_amdgcn_mfma_f32_32x32x16_bf16(k0, qr[d0], p0v, 0, 0, 0); p1v = __builtin_amdgcn_mfma_f32_32x32x16_bf16(k1, qr[d0], p1v, 0, 0, 0); } }
        if (s < nb) {
            const int kp0 = p0 - 128 + 64 * (tlo + s), qpos = p0 + r32;
#pragma unroll
            for (int r = 0; r < 16; ++r) { const int k0 = kp0 + crow(r, hi), k1 = k0 + 32;
                const bool v0 = (k0 >= 0) && (k0 < SEQ) && (k0 - qpos <= 128) && (qpos - k0 <= 128);
                const bool v1 = (k1 >= 0) && (k1 < SEQ) && (k1 - qpos <= 128) && (qpos - k1 <= 128);
                p0v[r] = v0 ? p0v[r] : -INFINITY; p1v[r] = v1 ? p1v[r] : -INFINITY; }
        }
        float tm = p0v[0];
#pragma unroll
        for (int r = 1; r < 16; ++r) tm = fmaxf(tm, p0v[r]);
#pragma unroll
        for (int r = 0; r < 16; ++r) tm = fmaxf(tm, p1v[r]);
        tm = swapmax(tm);
        const float mnew = fmaxf(mrun, tm);
        const float alpha = __builtin_amdgcn_exp2f(mrun - mnew);
        float ls = 0.f;
#pragma unroll
        for (int r = 0; r < 16; ++r) { p0v[r] = __builtin_amdgcn_exp2f(p0v[r] - mnew); p1v[r] = __builtin_amdgcn_exp2f(p1v[r] - mnew); ls += p0v[r] + p1v[r]; }
        lrun = lrun * alpha + ls; mrun = mnew;
#pragma unroll
        for (int r = 0; r < 16; ++r) { o[0][r] *= alpha; o[1][r] *= alpha; }
        v4u pw[4];
#pragma unroll
        for (int q = 0; q < 4; ++q) { pw[0][q] = cvt_pk_bf16(p0v[2 * q], p0v[2 * q + 1]); pw[1][q] = cvt_pk_bf16(p0v[8 + 2 * q], p0v[8 + 2 * q + 1]);
            pw[2][q] = cvt_pk_bf16(p1v[2 * q], p1v[2 * q + 1]); pw[3][q] = cvt_pk_bf16(p1v[8 + 2 * q], p1v[8 + 2 * q + 1]); }
#pragma unroll
        for (int dh = 0; dh < 2; ++dh)
#pragma unroll
            for (int ks = 0; ks < 4; ++ks) { const s16x4 lo = vtr(Vs + vlane + dh * 4096 + ks * 1024), hh = vtr(Vs + vlane + dh * 4096 + ks * 1024 + 512);
                const bf16x8 vf = (bf16x8){lo[0], lo[1], lo[2], lo[3], hh[0], hh[1], hh[2], hh[3]};
                o[dh] = __builtin_amdgcn_mfma_f32_32x32x16_bf16(vf, __builtin_bit_cast(bf16x8, pw[ks]), o[dh], 0, 0, 0); }
        if (s + 1 < ntile) ATT_WRITE_TILE((s + 1) & 1);
    }
    float lt = swapsum(lrun) + __builtin_amdgcn_exp2f(sink[hq] * LOG2E - mrun);
    const float inv = 1.0f / lt; float ssq = 0.f;
#pragma unroll
    for (int r = 0; r < 16; ++r) { o[0][r] *= inv; o[1][r] *= inv; ssq += o[0][r] * o[0][r] + o[1][r] * o[1][r]; }
    ssq = swapsum(ssq);
    if (hi == 0) xch[wid * 32 + r32] = ssq;
    __syncthreads();
    float tot = 0.f;
#pragma unroll
    for (int w = 0; w < 8; ++w) tot += xch[w * 32 + r32];
    const float rstd = 1.0f / sqrtf(tot * (1.0f / 512.0f) + EPS);
    bf16* orow = O + (size_t)(rowbase + p0 + r32) * DM + hq * 64;
#pragma unroll
    for (int dh = 0; dh < 2; ++dh)
#pragma unroll
        for (int rg = 0; rg < 4; ++rg) { const int d = 32 * dh + 8 * rg + 4 * hi; const f32x4 gg = *(const f32x4*)(g_attn + hq * 64 + d);
            v2u w; w.x = cvt_pk_bf16(o[dh][4 * rg] * rstd * gg[0], o[dh][4 * rg + 1] * rstd * gg[1]); w.y = cvt_pk_bf16(o[dh][4 * rg + 2] * rstd * gg[2], o[dh][4 * rg + 3] * rstd * gg[3]);
            *(v2u*)(orow + d) = w; }
    __syncthreads();
}

__device__ __forceinline__ void sgu_unit(Frame& F, int b, int ch) {
    const bf16* GV = (const bf16*)(F.ws + WS_GV); const bf16* U = (const bf16*)(F.ws + WS_U); const bf16* SW = (const bf16*)(F.ws + WS_SGUW); bf16* O = (bf16*)(F.ws + WS_O);
    const float* ln_g = F.in[13]; const float* ln_b = F.in[14]; const float* sgub = F.in[16]; const float* g_sgu = F.in[18];
    const int lane = F.lane, wid = F.wave, r0 = b * SEQ + ch * 128;
    LAS unsigned char* lds = F.lds; LAS float* xch = (LAS float*)(F.lds + L_XCH);
    { const int c0 = lane * 8; const f32x4 g0 = *(const f32x4*)(ln_g + c0), g1 = *(const f32x4*)(ln_g + c0 + 4), b0 = *(const f32x4*)(ln_b + c0), b1 = *(const f32x4*)(ln_b + c0 + 4);
      const int hh = lane >> 3, cc = (lane & 7) * 8;
      for (int jj = 0; jj < 16; ++jj) { const int j = wid * 16 + jj;
          const v4u raw = *(const v4u*)(GV + (size_t)(r0 + j) * 512 + c0);
          float x[8] = {bflo(raw.x), bfhi(raw.x), bflo(raw.y), bfhi(raw.y), bflo(raw.z), bfhi(raw.z), bflo(raw.w), bfhi(raw.w)};
          float s = 0.f;
#pragma unroll
          for (int q = 0; q < 8; ++q) s += x[q];
          const float mean = wave_sum(s) * (1.0f / 512.0f); float s2 = 0.f;
#pragma unroll
          for (int q = 0; q < 8; ++q) { x[q] -= mean; s2 += x[q] * x[q]; }
          const float rstd = 1.0f / sqrtf(wave_sum(s2) * (1.0f / 512.0f) + EPS);
          v4u o; o.x = cvt_pk_bf16(x[0] * rstd * g0[0] + b0[0], x[1] * rstd * g0[1] + b0[1]); o.y = cvt_pk_bf16(x[2] * rstd * g0[2] + b0[2], x[3] * rstd * g0[3] + b0[3]);
          o.z = cvt_pk_bf16(x[4] * rstd * g1[0] + b1[0], x[5] * rstd * g1[1] + b1[1]); o.w = cvt_pk_bf16(x[6] * rstd * g1[2] + b1[2], x[7] * rstd * g1[3] + b1[3]);
          *(LAS v4u*)(lds + hh * 16384 + ((j >> 3) * 2 + (cc >> 5)) * 512 + (j & 7) * 64 + (cc & 31) * 2) = o; } }
    __syncthreads();
    const int h = wid, kg = lane >> 4, il = lane & 15, q4 = il >> 2, p4 = il & 3;
    const LAS unsigned char* img = lds + h * 16384;
#pragma unroll 1
    for (int ip = 0; ip < 2; ++ip) {
        f32x4 acc[4][4];
#pragma unroll
        for (int cm = 0; cm < 4; ++cm)
#pragma unroll
            for (int in = 0; in < 4; ++in) acc[cm][in] = (f32x4){0.f, 0.f, 0.f, 0.f};
#pragma unroll 1
        for (int ks = 0; ks < 4; ++ks) {
            bf16x8 af[4], bfr[4];
#pragma unroll
            for (int cm = 0; cm < 4; ++cm) { const int off = ((4 * ks + kg) * 2 + (cm >> 1)) * 512 + q4 * 64 + (16 * (cm & 1) + 4 * p4) * 2;
                const s16x4 lo = vtr(img + off), hh2 = vtr(img + off + 256); af[cm] = (bf16x8){lo[0], lo[1], lo[2], lo[3], hh2[0], hh2[1], hh2[2], hh2[3]}; }
#pragma unroll
            for (int in = 0; in < 4; ++in) bfr[in] = *(const bf16x8*)(SW + (size_t)(h * 128 + 64 * ip + 16 * in + il) * 128 + 32 * ks + 8 * kg);
#pragma unroll
            for (int cm = 0; cm < 4; ++cm)
#pragma unroll
                for (int in = 0; in < 4; ++in) acc[cm][in] = __builtin_amdgcn_mfma_f32_16x16x32_bf16(af[cm], bfr[in], acc[cm][in], 0, 0, 0);
        }
#pragma unroll
        for (int in = 0; in < 4; ++in) { const int i = 64 * ip + 16 * in + il; const float bs = sgub[h * 128 + i]; float ss = 0.f;
#pragma unroll
            for (int cm = 0; cm < 4; ++cm) { const int c = h * 64 + 16 * cm + 4 * kg; const v2u ur = *(const v2u*)(U + (size_t)(r0 + i) * 512 + c);
                f32x4 v = acc[cm][in]; v[0] = (v[0] + bs) * bflo(ur.x); v[1] = (v[1] + bs) * bfhi(ur.x); v[2] = (v[2] + bs) * bflo(ur.y); v[3] = (v[3] + bs) * bfhi(ur.y);
                acc[cm][in] = v; ss += (v[0] * v[0] + v[1] * v[1]) + (v[2] * v[2] + v[3] * v[3]); }
            ss += __shfl_xor(ss, 16); ss += __shfl_xor(ss, 32);
            if (lane < 16) xch[h * 64 + 16 * in + il] = ss; }
        __syncthreads();
#pragma unroll
        for (int in = 0; in < 4; ++in) { const int i = 64 * ip + 16 * in + il; float tot = 0.f;
#pragma unroll
            for (int w = 0; w < 8; ++w) tot += xch[w * 64 + 16 * in + il];
            const float rstd = 1.0f / sqrtf(tot * (1.0f / 512.0f) + EPS);
#pragma unroll
            for (int cm = 0; cm < 4; ++cm) { const int c = h * 64 + 16 * cm + 4 * kg; const f32x4 gg = *(const f32x4*)(g_sgu + c); const f32x4 v = acc[cm][in];
                v2u w; w.x = cvt_pk_bf16(v[0] * rstd * gg[0], v[1] * rstd * gg[1]); w.y = cvt_pk_bf16(v[2] * rstd * gg[2], v[3] * rstd * gg[3]);
                *(v2u*)(O + (size_t)(r0 + i) * DM + 512 + c) = w; } }
        __syncthreads();
    }
}


__device__ __forceinline__ void naive_attn_token(Frame& F, int tok) {
    const bf16* Q = (const bf16*)(F.ws + WS_Q); const bf16* Kx = (const bf16*)(F.ws + WS_K); const bf16* Vx = (const bf16*)(F.ws + WS_V);
    const bf16* KC = (const bf16*)(F.ws + WS_KC); const bf16* VC = (const bf16*)(F.ws + WS_VC); bf16* O = (bf16*)(F.ws + WS_O);
    const int lane = F.lane, h = F.wave, kvh = h >> 2, b = tok >> 12, pos = tok & (SEQ - 1);
    LAS float* qs = (LAS float*)(F.lds) + h * 64; LAS float* sc = (LAS float*)(F.lds + 4096) + h * 768; LAS float* xs = (LAS float*)(F.lds + L_XCH);
    qs[lane] = bflo((unsigned)Q[(size_t)tok * 512 + h * 64 + lane]);
    __syncthreads();
    const int lo = pos - 128 < 0 ? 0 : pos - 128, hi = pos + 128 > SEQ - 1 ? SEQ - 1 : pos + 128, nband = hi - lo + 1, nk = nband + LC;
    float mx = F.in[12][h] * LOG2E;
    for (int base = 0; base < nk; base += 64) { const int idx = base + lane; float s = -INFINITY;
        if (idx < nk) { const bf16* kp = idx < nband ? Kx + (size_t)(b * SEQ + lo + idx) * 128 + kvh * 64 : KC + (size_t)(b * LC + idx - nband) * 128 + kvh * 64;
            s = 0.f; for (int d = 0; d < 64; ++d) s += qs[d] * bflo((unsigned)kp[d]); sc[idx] = s; }
        mx = fmaxf(mx, s); }
#pragma unroll
    for (int o2 = 1; o2 < 64; o2 <<= 1) mx = fmaxf(mx, __shfl_xor(mx, o2));
    __syncthreads();
    float l = 0.f, acc = 0.f;
    for (int idx = 0; idx < nk; ++idx) { const float p = __builtin_amdgcn_exp2f(sc[idx] - mx); l += p;
        const bf16* vp = idx < nband ? Vx + (size_t)(b * SEQ + lo + idx) * 128 + kvh * 64 : VC + (size_t)(b * LC + idx - nband) * 128 + kvh * 64;
        acc += p * bflo((unsigned)vp[lane]); }
    l += __builtin_amdgcn_exp2f(F.in[12][h] * LOG2E - mx);
    const float ov = acc / l; const float ss = wave_sum(ov * ov);
    if (lane == 0) xs[h] = ss;
    __syncthreads();
    float tot = 0.f;
    for (int w = 0; w < 8; ++w) tot += xs[w];
    const float rstd = 1.0f / sqrtf(tot * (1.0f / 512.0f) + EPS);
    O[(size_t)tok * DM + h * 64 + lane] = (bf16)f2bf(ov * rstd * F.in[17][h * 64 + lane]);
    __syncthreads();
}
__device__ __forceinline__ void naive_sgu_unit(Frame& F, int b, int ch) {
    const bf16* GV = (const bf16*)(F.ws + WS_GV); const bf16* U = (const bf16*)(F.ws + WS_U); bf16* O = (bf16*)(F.ws + WS_O);
    const float* ln_g = F.in[13]; const float* ln_b = F.in[14]; const float* sw = F.in[15]; const float* sgub = F.in[16]; const float* g_sgu = F.in[18];
    const int lane = F.lane, wid = F.wave, tid = F.tid, r0 = b * SEQ + ch * 128;
    LAS float* vl = (LAS float*)F.lds;
    LAS float* xs = (LAS float*)(F.lds + L_XCH);
    LAS float* st = xs + 16;
    for (int jj = 0; jj < 16; ++jj) { const int j = wid * 16 + jj; float x[8]; float s = 0.f;
#pragma unroll
        for (int q = 0; q < 8; ++q) { x[q] = bflo((unsigned)GV[(size_t)(r0 + j) * 512 + lane * 8 + q]); s += x[q]; }
        const float mean = wave_sum(s) * (1.0f / 512.0f); float s2 = 0.f;
#pragma unroll
        for (int q = 0; q < 8; ++q) { const float d = x[q] - mean; s2 += d * d; }
        const float rstd = 1.0f / sqrtf(wave_sum(s2) * (1.0f / 512.0f) + EPS);
        if (lane == 0) { st[2 * j] = mean; st[2 * j + 1] = rstd; } }
    __syncthreads();
    const int c = tid, h = c >> 6;
    for (int i = 0; i < 128; ++i) {
        float m = 0.f;
        for (int j = 0; j < 128; ++j) { const float gv = bflo((unsigned)GV[(size_t)(r0 + j) * 512 + c]); const float y = (gv - st[2 * j]) * st[2 * j + 1] * ln_g[c] + ln_b[c]; m += sw[(size_t)(h * 128 + i) * 128 + j] * y; }
        const float v = (m + sgub[h * 128 + i]) * bflo((unsigned)U[(size_t)(r0 + i) * 512 + c]);
        const float ss = wave_sum(v * v);
        __syncthreads();
        if (lane == 0) xs[wid] = ss;
        __syncthreads();
        float tot = 0.f;
        for (int w = 0; w < 8; ++w) tot += xs[w];
        const float rstd = 1.0f / sqrtf(tot * (1.0f / 512.0f) + EPS);
        O[(size_t)(r0 + i) * DM + 512 + c] = (bf16)f2bf(v * rstd * g_sgu[c]);
    }
    __syncthreads();
}


constexpr int CW_FLAGS = 32768;
__device__ __forceinline__ double dcos_red(double a) { const double tp = 6.283185307179586; a -= tp * floor(a / tp + 0.5); double t = 1.0, s = 1.0; for (int i = 1; i < 16; ++i) { t *= -a * a / ((2.0 * i - 1.0) * (2.0 * i)); s += t; } return s; }
__device__ __forceinline__ double dsin_red(double a) { const double tp = 6.283185307179586; a -= tp * floor(a / tp + 0.5); double t = a, s = a; for (int i = 1; i < 16; ++i) { t *= -a * a / ((2.0 * i) * (2.0 * i + 1.0)); s += t; } return s; }
__device__ __forceinline__ bool close_to(float got, float want, float atol, float rtol) { return fabsf(got - want) <= atol + rtol * fabsf(want); }
__device__ __forceinline__ void debug_checks(Frame& F) {
    const float* MOD = (const float*)(F.ws + WS_MOD); const bf16* H = (const bf16*)(F.ws + WS_H);
    const bf16* Q = (const bf16*)(F.ws + WS_Q); const bf16* Kx = (const bf16*)(F.ws + WS_K); const bf16* Vx = (const bf16*)(F.ws + WS_V);
    const bf16* KC = (const bf16*)(F.ws + WS_KC); const bf16* VC = (const bf16*)(F.ws + WS_VC); const bf16* U = (const bf16*)(F.ws + WS_U); const bf16* GV = (const bf16*)(F.ws + WS_GV);
    const bf16* O = (const bf16*)(F.ws + WS_O); const bf16* MIX = (const bf16*)(F.ws + WS_MIX);
    const int gw = blockIdx.x * NWAVES + F.wave, lane = F.lane;
    unsigned bad = 0u;
    for (int q = 0; q < 4; ++q) { const unsigned hsh = (unsigned)(gw * 4 + q) * 2654435761u; const int r = (hsh >> 8) % 9, n = (hsh >> 12) % NMOD;
        float a = 0.f; for (int k = lane; k < DM; k += 64) { const float v = r < 8 ? F.in[1][r * DM + k] : F.in[3][k]; a += v / (1.0f + expf(-v)) * F.in[4][(size_t)k * NMOD + n]; }
        a = wave_sum(a) + F.in[5][n];
        if (!close_to(MOD[r * NMOD + n], a, 1e-3f, 1e-3f)) bad |= 1u; }
    for (int q = 0; q < 2; ++q) { const unsigned hsh = (unsigned)(gw * 2 + q) * 2246822519u; const int m = (hsh >> 7) % (TT + TC);
        const float* xrow = m < TT ? F.in[0] + (size_t)m * DM : F.in[2] + (size_t)(m - TT) * DM; const float* md = MOD + (m < TT ? (m >> 12) : 8) * NMOD;
        float ss = 0.f; for (int k = lane; k < DM; k += 64) ss += xrow[k] * xrow[k];
        const float rstd = 1.0f / sqrtf(wave_sum(ss) / DM + EPS);
        for (int k = lane; k < DM; k += 64) { const float want = xrow[k] * rstd * F.in[6][k] * (1.0f + md[DM + k]) + md[k];
            if (!close_to(bflo((unsigned)H[(size_t)m * DM + k]), want, 2e-2f, 1e-2f)) bad |= 2u; } }
    for (int q = 0; q < 8; ++q) { const unsigned hsh = (unsigned)(gw * 8 + q) * 3266489917u; const int kind = q;
        const int row = kind == 7 ? TT + (int)((hsh >> 6) % TC) : (int)((hsh >> 6) % TT); const int d = (hsh >> 3) & 15;
        int n1, n2;
        if (kind < 2) { const int hd = (hsh >> 20) & 7; n1 = hd * 64 + (kind & 1) * 32 + d; n2 = n1 + 16; }
        else if (kind < 4) { const int hd = (hsh >> 20) & 1; n1 = 512 + hd * 64 + (kind & 1) * 32 + d; n2 = n1 + 16; }
        else if (kind == 4) { n1 = 640 + ((hsh >> 20) & 127); n2 = n1; }
        else if (kind == 5) { n1 = 768 + ((hsh >> 20) & 511); n2 = n1; }
        else if (kind == 6) { n1 = 1280 + ((hsh >> 20) & 511); n2 = n1; }
        else { n1 = 512 + ((hsh >> 20) & 127); n2 = n1 + 128; }
        float a1 = 0.f, a2 = 0.f;
        for (int k = lane; k < DM; k += 64) { const float hv = bflo((unsigned)H[(size_t)row * DM + k]); a1 += hv * F.in[10][(size_t)k * NIN + n1]; a2 += hv * F.in[10][(size_t)k * NIN + n2]; }
        a1 = wave_sum(a1) + F.in[11][n1]; a2 = wave_sum(a2) + F.in[11][n2];
        if (kind < 4) { const int t = row & (SEQ - 1); const int pos = (kind & 1) ? (t & 63) : (t >> 6);
            const double ang = (double)pos * pow(10000.0, -(double)d / 16.0); const float cs = (float)dcos_red(ang), sn = (float)dsin_red(ang);
            float w1 = a1 * cs - a2 * sn, w2 = a2 * cs + a1 * sn; if (kind < 2) { w1 *= QSCALE; w2 *= QSCALE; }
            const float g1 = kind < 2 ? bflo((unsigned)Q[(size_t)row * 512 + n1]) : bflo((unsigned)Kx[(size_t)row * 128 + n1 - 512]);
            const float g2 = kind < 2 ? bflo((unsigned)Q[(size_t)row * 512 + n2]) : bflo((unsigned)Kx[(size_t)row * 128 + n2 - 512]);
            if (!close_to(g1, w1, 3e-2f, 3e-2f) || !close_to(g2, w2, 3e-2f, 3e-2f)) bad |= (kind < 2 ? 4u : 8u); }
        else if (kind == 4) { if (!close_to(bflo((unsigned)Vx[(size_t)row * 128 + n1 - 640]), a1, 3e-2f, 3e-2f)) bad |= 16u; }
        else if (kind == 5 || kind == 6) { const float u0 = 0.7978845608f * (a1 + 0.044715f * a1 * a1 * a1); const float want = 0.5f * a1 * (1.0f + tanhf(u0));
            const float got = kind == 5 ? bflo((unsigned)U[(size_t)row * 512 + n1 - 768]) : bflo((unsigned)GV[(size_t)row * 512 + n1 - 1280]);
            if (!close_to(got, want, 3e-2f, 3e-2f)) bad |= 32u; }
        else { const float g1 = bflo((unsigned)KC[(size_t)(row - TT) * 128 + n1 - 512]), g2 = bflo((unsigned)VC[(size_t)(row - TT) * 128 + n1 - 512]);
            if (!close_to(g1, a1, 3e-2f, 3e-2f) || !close_to(g2, a2, 3e-2f, 3e-2f)) bad |= 64u; }
    }
    for (int q = 0; q < 2; ++q) { const unsigned hsh = (unsigned)(gw * 2 + q) * 668265263u; const int row = (hsh >> 6) % TT, n = (hsh >> 22) & 1023;
        float a = 0.f; for (int k = lane; k < DM; k += 64) a += bflo((unsigned)O[(size_t)row * DM + k]) * F.in[19][(size_t)k * DM + n];
        a = wave_sum(a) + F.in[20][n];
        if (!close_to(bflo((unsigned)MIX[(size_t)row * DM + n]), a, 5e-2f, 3e-2f)) bad |= 128u; }
    if (bad && lane == 0) atomicOr((unsigned*)(F.ctl + CW_FLAGS), bad);
}

__device__ __forceinline__ void p5_rows(Frame& F) {
    const float* MOD = (const float*)(F.ws + WS_MOD); const bf16* MIX = (const bf16*)(F.ws + WS_MIX); unsigned char* H2 = F.ws + WS_H2;
    float* GATES = (float*)(F.ws + WS_GATES); int* ROWDST = (int*)(F.ws + WS_ROWDST);
    const float* g_post = F.in[7]; const float* g_pre = F.in[8]; const float* w_router = F.in[21]; const float* b_router = F.in[22];
    const int lane = F.lane, wid = F.wave, tid = F.tid;
    LAS float* wl = (LAS float*)F.lds;
    LAS int* lcount = (LAS int*)(F.lds + L_SEL); LAS int* lbase = lcount + 32; LAS int* sel_e = lcount + 64; LAS int* sel_slot = lcount + 64 + 512;
    for (int q = tid; q < 8192; q += NWAVES * 64) { const int k = q >> 3, ec = q & 7; const f32x4 v = *(const f32x4*)(w_router + k * 32 + 4 * ec);
        const int l = (k & 255) >> 2, j = k >> 8, i4 = k & 3; *(LAS f32x4*)(wl + (((j * 4 + i4) * 8 + ec) * 64 + l) * 4) = v; }
    if (tid < 32) lcount[tid] = 0;
    __syncthreads();
    for (int chunk = blockIdx.x; chunk < TT / 128; chunk += F.G) {
        for (int tt = 0; tt < 16; ++tt) {
            const int tokl = wid * 16 + tt, tok = chunk * 128 + tokl, bb = tok >> 12;
            const float* md = MOD + bb * NMOD;
            const GAS f32x4* xr = (const GAS f32x4*)(F.in[0] + (size_t)tok * DM) + lane;
            const GAS v2u* mr = (const GAS v2u*)(MIX + (size_t)tok * DM) + lane;
            f32x4 xv[4], mv[4]; float s = 0.f;
#pragma unroll
            for (int j = 0; j < 4; ++j) { xv[j] = xr[64 * j]; const v2u m2 = mr[64 * j]; mv[j] = (f32x4){bflo(m2.x), bfhi(m2.x), bflo(m2.y), bfhi(m2.y)};
                s += (mv[j].x * mv[j].x + mv[j].y * mv[j].y) + (mv[j].z * mv[j].z + mv[j].w * mv[j].w); }
            const float rstd1 = 1.0f / sqrtf(wave_sum(s) * (1.0f / DM) + EPS);
            float s2 = 0.f;
            GAS f32x4* xo = (GAS f32x4*)(F.out + (size_t)tok * DM) + lane;
#pragma unroll
            for (int j = 0; j < 4; ++j) { const int col = 4 * lane + 256 * j; const f32x4 gp = *(const f32x4*)(g_post + col), gt = *(const f32x4*)(md + 2 * DM + col);
                xv[j] = xv[j] + gt * (mv[j] * rstd1 * gp); xo[64 * j] = xv[j];
                s2 += (xv[j].x * xv[j].x + xv[j].y * xv[j].y) + (xv[j].z * xv[j].z + xv[j].w * xv[j].w); }
            const float rstd2 = 1.0f / sqrtf(wave_sum(s2) * (1.0f / DM) + EPS);
            GAS unsigned* ho = (GAS unsigned*)(H2 + (size_t)tok * DM) + lane;
#pragma unroll
            for (int j = 0; j < 4; ++j) { const int col = 4 * lane + 256 * j; const f32x4 gp = *(const f32x4*)(g_pre + col), sh = *(const f32x4*)(md + 3 * DM + col), sc = *(const f32x4*)(md + 4 * DM + col);
                xv[j] = xv[j] * rstd2 * gp * (sc + 1.0f) + sh; ho[64 * j] = pk4_fp8(xv[j].x * H2_SCALE, xv[j].y * H2_SCALE, xv[j].z * H2_SCALE, xv[j].w * H2_SCALE); }
            float a[32];
#pragma unroll
            for (int e = 0; e < 32; ++e) a[e] = 0.f;
#pragma unroll
            for (int j = 0; j < 4; ++j)
#pragma unroll
                for (int i4 = 0; i4 < 4; ++i4) { const float hv = xv[j][i4];
#pragma unroll
                    for (int ec = 0; ec < 8; ++ec) { const f32x4 w4 = *(const LAS f32x4*)(wl + (((j * 4 + i4) * 8 + ec) * 64 + lane) * 4);
                        a[4 * ec] += hv * w4[0]; a[4 * ec + 1] += hv * w4[1]; a[4 * ec + 2] += hv * w4[2]; a[4 * ec + 3] += hv * w4[3]; } }
#pragma unroll
            for (int i = 0; i < 16; ++i) { const bool up = (lane & 32) != 0; const float send = up ? a[i] : a[i + 16], keep = up ? a[i + 16] : a[i]; a[i] = keep + __shfl_xor(send, 32); }
#pragma unroll
            for (int i = 0; i < 8; ++i) { const bool up = (lane & 16) != 0; const float send = up ? a[i] : a[i + 8], keep = up ? a[i + 8] : a[i]; a[i] = keep + __shfl_xor(send, 16); }
#pragma unroll
            for (int i = 0; i < 4; ++i) { const bool up = (lane & 8) != 0; const float send = up ? a[i] : a[i + 4], keep = up ? a[i + 4] : a[i]; a[i] = keep + __shfl_xor(send, 8); }
#pragma unroll
            for (int i = 0; i < 2; ++i) { const bool up = (lane & 4) != 0; const float send = up ? a[i] : a[i + 2], keep = up ? a[i + 2] : a[i]; a[i] = keep + __shfl_xor(send, 4); }
            { const bool up = (lane & 2) != 0; const float send = up ? a[0] : a[1], keep = up ? a[1] : a[0]; a[0] = keep + __shfl_xor(send, 2); }
            float lg = a[0] + __shfl_xor(a[0], 1);
            lg += b_router[lane >> 1];
            int esel[4]; float vsel[4];
#pragma unroll
            for (int k = 0; k < 4; ++k) { float m = lg;
#pragma unroll
                for (int o2 = 2; o2 < 64; o2 <<= 1) m = fmaxf(m, __shfl_xor(m, o2));
                const unsigned long long mask = __ballot(lg == m); const int first = __ffsll((long long)mask) - 1;
                esel[k] = first >> 1; vsel[k] = m; if ((lane >> 1) == esel[k]) lg = -INFINITY; }
            float wk[4], wsum = 0.f;
#pragma unroll
            for (int k = 0; k < 4; ++k) { wk[k] = __expf(vsel[k] - vsel[0]); wsum += wk[k]; }
            if (lane < 4) { const float gk = (lane == 0 ? wk[0] : lane == 1 ? wk[1] : lane == 2 ? wk[2] : wk[3]) / wsum; const int ek = lane == 0 ? esel[0] : lane == 1 ? esel[1] : lane == 2 ? esel[2] : esel[3];
                GATES[(size_t)tok * 4 + lane] = gk;
                const int slot = __hip_atomic_fetch_add(lcount + ek, 1, __ATOMIC_RELAXED, __HIP_MEMORY_SCOPE_WORKGROUP);
                sel_e[tokl * 4 + lane] = ek; sel_slot[tokl * 4 + lane] = slot; }
        }
        __syncthreads();
        if (tid < 32) lbase[tid] = (int)__hip_atomic_fetch_add((unsigned*)(F.ctl + CW_CNT + 64 * tid), (unsigned)lcount[tid], RLX_AGENT);
        __syncthreads();
        { const int e = sel_e[tid]; ROWDST[(size_t)e * ECAP + lbase[e] + sel_slot[tid]] = (chunk * 128 + (tid >> 2)) * 4 + (tid & 3); }
        __syncthreads();
        if (tid < 32) lcount[tid] = 0;
        __syncthreads();
    }
}

__device__ __forceinline__ void moe_tables(Frame& F) {
    LAS unsigned char* tile_e = F.lds + L_TILEE; LAS int* tab = (LAS int*)(F.lds + L_CNT);
    __syncthreads();
    if (F.tid < 32) tab[F.tid] = (int)__hip_atomic_load((unsigned*)(F.ctl + CW_CNT + 64 * F.tid), RLX_AGENT);
    __syncthreads();
    if (F.tid == 0) { int acc = 0; for (int e = 0; e < 32; ++e) { tab[32 + e] = acc; acc += (tab[e] + 255) >> 8; } tab[64] = acc; tab[65] = acc < MAXTILES ? acc : MAXTILES; }
    __syncthreads();
    for (int e = F.wave; e < 32; e += NWAVES) { const int f = tab[32 + e], n = (tab[e] + 255) >> 8; for (int q = F.lane; q < n; q += 64) if (f + q < MAXTILES) tile_e[f + q] = (unsigned char)e; }
    __syncthreads();
}

__device__ __forceinline__ void p8_final(Frame& F) {
    const float* MOD = (const float*)(F.ws + WS_MOD); const bf16* Y4 = (const bf16*)(F.ws + WS_Y4); const float* GATES = (const float*)(F.ws + WS_GATES); const float* g_post = F.in[9];
    const int gw = F.vcu * NWAVES + F.wave, NGW = F.G * NWAVES, lane = F.lane;
    for (int tok = gw; tok < TT; tok += NGW) {
        const f32x4 gt = *(const f32x4*)(GATES + (size_t)tok * 4);
        const float* md = MOD + (tok >> 12) * NMOD + 5 * DM;
        f32x4 y[4]; float s = 0.f;
#pragma unroll
        for (int j = 0; j < 4; ++j) y[j] = (f32x4){0.f, 0.f, 0.f, 0.f};
#pragma unroll
        for (int k = 0; k < 4; ++k) { const GAS v2u* yr = (const GAS v2u*)(Y4 + ((size_t)tok * 4 + k) * DM) + lane; const float gk = gt[k];
#pragma unroll
            for (int j = 0; j < 4; ++j) { const v2u m2 = yr[64 * j]; y[j] = y[j] + (f32x4){bflo(m2.x), bfhi(m2.x), bflo(m2.y), bfhi(m2.y)} * gk; } }
#pragma unroll
        for (int j = 0; j < 4; ++j) s += (y[j].x * y[j].x + y[j].y * y[j].y) + (y[j].z * y[j].z + y[j].w * y[j].w);
        const float rstd = 1.0f / sqrtf(wave_sum(s) * (1.0f / DM) + EPS);
        GAS f32x4* xo = (GAS f32x4*)(F.out + (size_t)tok * DM) + lane;
#pragma unroll
        for (int j = 0; j < 4; ++j) { const int col = 4 * lane + 256 * j; const f32x4 gp = *(const f32x4*)(g_post + col), g2 = *(const f32x4*)(md + col);
            const f32x4 xm = xo[64 * j];
            if (PROBE == 1) xo[64 * j] = xm;
            else if (PROBE == 2) xo[64 * j] = *((const GAS f32x4*)(F.in[0] + (size_t)tok * DM) + lane + 64 * j);
#if CHECKS
            else if (PROBE == 3) { const unsigned fl = __hip_atomic_load((unsigned*)(F.ctl + 32768), RLX_AGENT); const float scl = 1.0f + (float)((fl >> CHECK_BIT) & 15u) * 0.125f; xo[64 * j] = (xm + g2 * (y[j] * rstd * gp)) * scl; }
#endif
            else xo[64 * j] = xm + g2 * (y[j] * rstd * gp); }
    }
}

constexpr int N_LAUNCHES = MK_N_LAUNCHES;
constexpr int PER_PHASE = 9;
struct Args { const float* in[27]; float* out; unsigned char* ws; int ph_lo, ph_hi; };
__global__ void __launch_bounds__(NWAVES * 64, 2) fwd_kernel(Args args) {
    extern __shared__ __attribute__((aligned(16))) unsigned char lds_raw[];
    Frame F;
    F.lds = (LAS unsigned char*)lds_raw;
    F.tid = threadIdx.x; F.lane = F.tid & 63; F.wave = __builtin_amdgcn_readfirstlane(F.tid >> 6);
    F.G = gridDim.x; { const int bx = blockIdx.x; F.vcu = (F.G % 8 == 0) ? (bx % 8) * (F.G / 8) + bx / 8 : bx; }
#pragma unroll
    for (int i = 0; i < 27; ++i) F.in[i] = args.in[i];
    F.out = args.out; F.ws = args.ws; F.ctl = (gu32*)(args.ws + WS_CTL);
    for (int u = F.tid; u < (LDS_BYTES - MISC_OFF) / 4; u += NWAVES * 64) ((LAS unsigned*)(F.lds + MISC_OFF))[u] = 0u;
    __syncthreads();
    XcdBarrier bar; bar.bar = (unsigned*)(F.ctl + CW_BAR); bar.x = 0; bar.st = nullptr;
    if (N_LAUNCHES != PER_PHASE) bar = xcd_barrier_post((unsigned*)(F.ctl + CW_BAR), (volatile LAS unsigned*)(F.lds + L_BARW));
#define GRID_BAR() do { if (N_LAUNCHES == PER_PHASE) { if (F.tid == 0) __hip_atomic_store(F.ctl + CW_TMO, 0xBADBA0u, RLX_AGENT); } else { xcd_barrier(bar); } } while (0)
    const int lo = args.ph_lo, hi = args.ph_hi;
#define IN(k) (lo <= (k) && (k) < hi)
#define BOTH(k) (IN(k) && IN((k) + 1))

#define REFRESH() do { int t_ = threadIdx.x; asm volatile("" : "+v"(t_)); F.tid = t_; F.lane = t_ & 63; F.wave = __builtin_amdgcn_readfirstlane(t_ >> 6); \
        const __attribute__((address_space(4))) Args* ap_ = (const __attribute__((address_space(4))) Args*)__builtin_amdgcn_kernarg_segment_ptr(); asm volatile("" : "+s"(ap_)); \
        _Pragma("unroll") for (int i_ = 0; i_ < 27; ++i_) F.in[i_] = ap_->in[i_]; F.out = ap_->out; F.ws = ap_->ws; F.ctl = (gu32*)(ap_->ws + WS_CTL); } while (0)
#define REP(k) _Pragma("unroll") for (int rep_ = 0; rep_ < (DUP_PHASE == (k) ? 2 : 1); ++rep_)
    if (IN(0)) { REFRESH(); REP(0) { p0_prologue(F); if (BOTH(0)) GRID_BAR(); } }
    if (IN(1)) { REFRESH(); REP(1) { p1_prenorm(F); if (BOTH(1)) GRID_BAR(); } }
    if (IN(2)) { REFRESH(); REP(2) {
        pg8::SchedIn S{F.G, (int)blockIdx.x};
        pg8::EpiInProj E{F.in[11], (bf16*)(F.ws + WS_Q), (bf16*)(F.ws + WS_K), (bf16*)(F.ws + WS_V), (bf16*)(F.ws + WS_KC), (bf16*)(F.ws + WS_VC), (bf16*)(F.ws + WS_U), (bf16*)(F.ws + WS_GV), (const float*)(F.ws + WS_ROPE)};
        pg8::gemm_phase<pg8::EpiInProj, pg8::SchedIn, 0, true>(F.lds, (const bf16*)(F.ws + WS_H), (const bf16*)(F.ws + WS_WIN), DM, S, E);
        if (BOTH(2)) GRID_BAR();
    } }
    if (IN(3)) { REFRESH(); REP(3) {
#if NAIVE_ATTN
        for (int t = blockIdx.x; t < TT; t += F.G) naive_attn_token(F, t);
#else
        for (int u = F.vcu; u < NB * 128; u += F.G) attn_unit(F, u >> 7, u & 127);
#endif
#if NAIVE_SGU
        for (int u = F.vcu; u < NB * 32; u += F.G) naive_sgu_unit(F, u >> 5, u & 31);
#else
        for (int u = F.vcu; u < NB * 32; u += F.G) sgu_unit(F, u >> 5, u & 31);
#endif
        if (BOTH(3)) GRID_BAR();
    } }
    if (IN(4)) { REFRESH(); REP(4) {
        pg8::SchedOut S{F.G, (int)blockIdx.x};
        pg8::EpiOut E{F.in[20], (bf16*)(F.ws + WS_MIX)};
        pg8::gemm_phase<pg8::EpiOut, pg8::SchedOut, 0, true>(F.lds, (const bf16*)(F.ws + WS_O), (const bf16*)(F.ws + WS_WOUT), DM, S, E);
        if (BOTH(4)) GRID_BAR();
    } }
#if CHECKS
    if (IN(5)) { debug_checks(F); __syncthreads(); }
#endif
    if (IN(5)) { REFRESH(); p5_rows(F); if (BOTH(5)) GRID_BAR(); }
    if (IN(6)) { REFRESH(); REP(6) {
        moe_tables(F);
        pg8::SchedMoe<8, 1> S{F.G, (int)blockIdx.x, F.lds + L_TILEE, (const LAS int*)(F.lds + L_CNT), (const int*)(F.ws + WS_ROWDST)};
        pg8::EpiSwiglu E{F.in[24], F.ws + WS_ACT};
        pg8::gemm_phase<pg8::EpiSwiglu, pg8::SchedMoe<8, 1>, 1, true, true>(F.lds, F.ws + WS_H2, F.ws + WS_WGU, DM, S, E);
        if (BOTH(6)) GRID_BAR();
    } }
    if (IN(7)) { REFRESH(); REP(7) {
        moe_tables(F);
        pg8::SchedMoe<4, 1> S{F.G, (int)blockIdx.x, F.lds + L_TILEE, (const LAS int*)(F.lds + L_CNT), (const int*)(F.ws + WS_ROWDST)};
        pg8::EpiDown E{F.in[26], (bf16*)(F.ws + WS_Y4)};
        pg8::gemm_phase<pg8::EpiDown, pg8::SchedMoe<4, 1>, 2, true, true>(F.lds, F.ws + WS_ACT, F.ws + WS_WD, FF, S, E);
        if (BOTH(7)) GRID_BAR();
    } }
    if (IN(8)) { REFRESH(); p8_final(F); }
#undef IN
#undef BOTH
}

extern "C" void kernel_launch(void* const* d_in, const int* in_sizes, int n_in, void* d_out, int out_size, void* d_ws, size_t ws_size, hipStream_t stream) {
    static int grid = 0;
    if (grid == 0) {
        if (n_in != 27 || in_sizes[0] != TT * DM || out_size != TT * DM || ws_size < WS_END) { fprintf(stderr, "kernel_launch: unexpected problem (n_in %d, in0 %d, out %d, ws %zu); nothing launched\n", n_in, n_in > 0 ? in_sizes[0] : -1, out_size, ws_size); grid = -1; return; }
        int dev = 0, cus = 0, per_cu = 0;
        if (hipGetDevice(&dev) != hipSuccess || hipDeviceGetAttribute(&cus, hipDeviceAttributeMultiprocessorCount, dev) != hipSuccess) { grid = -1; return; }
        if (hipFuncSetAttribute((const void*)fwd_kernel, hipFuncAttributeMaxDynamicSharedMemorySize, LDS_BYTES) != hipSuccess) { fprintf(stderr, "kernel_launch: hipFuncSetAttribute failed\n"); grid = -1; return; }
        if (hipOccupancyMaxActiveBlocksPerMultiprocessor(&per_cu, (const void*)fwd_kernel, NWAVES * 64, LDS_BYTES) != hipSuccess || per_cu < 1)
            fprintf(stderr, "kernel_launch: note: occupancy query reports %d workgroups per CU\n", per_cu);
        (void)hipGetLastError();
        grid = cus;
    }
    if (grid < 0) return;
    if (hipMemsetAsync((char*)d_ws + WS_CTL, 0, CTL_ZERO_BYTES, stream) != hipSuccess) { fprintf(stderr, "kernel_launch: memset failed\n"); return; }
    Args a{};
    for (int i = 0; i < 27; ++i) a.in[i] = (const float*)d_in[i];
    a.out = (float*)d_out; a.ws = (unsigned char*)d_ws;
    for (int li = 0; li < N_LAUNCHES; ++li) {
        if (N_LAUNCHES == PER_PHASE) { a.ph_lo = li; a.ph_hi = li + 1; } else { a.ph_lo = 0; a.ph_hi = PER_PHASE; }
        hipLaunchKernelGGL(fwd_kernel, dim3(grid), dim3(NWAVES * 64), LDS_BYTES, stream, a);
        const hipError_t le = hipPeekAtLastError();
        if (le != hipSuccess) { fprintf(stderr, "kernel_launch: launch %d failed: %s\n", li, hipGetErrorName(le)); break; }
    }
}
```

```cpp
#include <hip/hip_runtime.h>
#include <cstdio>
#include <cstdint>

#ifndef MK_N_LAUNCHES
#define MK_N_LAUNCHES 1
#endif
#ifndef PROBE
#define PROBE 0
#endif
#ifndef DUP_PHASE
#define DUP_PHASE -1
#endif
#ifndef CHECKS
#define CHECKS 0
#endif
#ifndef CHECK_BIT
#define CHECK_BIT 0
#endif
#ifndef NAIVE_ATTN
#define NAIVE_ATTN 0
#endif
#ifndef NAIVE_SGU
#define NAIVE_SGU 0
#endif
#ifndef GEMM_NAIVE
#define GEMM_NAIVE 0
#endif

#define GAS __attribute__((address_space(1)))
#define LAS __attribute__((address_space(3)))
typedef unsigned short bf16;
typedef unsigned v4u __attribute__((ext_vector_type(4)));
typedef unsigned v2u __attribute__((ext_vector_type(2)));
typedef float f32x4 __attribute__((ext_vector_type(4)));
typedef float f32x2 __attribute__((ext_vector_type(2)));
typedef float f32x16 __attribute__((ext_vector_type(16)));
typedef short bf16x8 __attribute__((ext_vector_type(8)));
typedef short s16x4 __attribute__((ext_vector_type(4)));
typedef int v4i_t __attribute__((ext_vector_type(4)));
typedef int v8i_t __attribute__((ext_vector_type(8)));
typedef GAS unsigned gu32;

constexpr int NB = 8, SEQ = 4096, DM = 1024, TT = NB * SEQ;
constexpr int LC = 256, TC = NB * LC;
constexpr int NIN = 1792, NE = 32, FF = 1024, NMOD = 6 * DM;
constexpr int ECAP = 32768;
constexpr int MAXTILES = 544;
constexpr float EPS = 1e-6f;
constexpr float LOG2E = 1.4426950408889634f;
constexpr float QSCALE = 0.125f * LOG2E;
constexpr float H2_SCALE = 8.0f, W_SCALE = 32.0f, ACT_SCALE = 4.0f;
constexpr float DQ1 = 1.0f / (H2_SCALE * W_SCALE), DQ2 = 1.0f / (ACT_SCALE * W_SCALE);

constexpr size_t MiB = 1u << 20;
constexpr size_t WS_CTL = 0, CTL_ZERO_BYTES = 1 * MiB;
constexpr size_t WS_MOD = 1 * MiB;
constexpr size_t WS_ROPE = 1 * MiB + 256 * 1024;
constexpr size_t WS_SGUW = 1 * MiB + 512 * 1024;
constexpr size_t WS_WIN = 2 * MiB;
constexpr size_t WS_WOUT = 6 * MiB;
constexpr size_t WS_WGU = 8 * MiB;
constexpr size_t WS_WD = 136 * MiB;
constexpr size_t WS_GATES = 200 * MiB;
constexpr size_t WS_ROWDST = 201 * MiB;
constexpr size_t WS_H2 = 206 * MiB;
constexpr size_t WS_Y4 = 270 * MiB;
constexpr size_t WS_H = 526 * MiB;
constexpr size_t WS_Q = 594 * MiB;
constexpr size_t WS_K = 626 * MiB;
constexpr size_t WS_V = 634 * MiB;
constexpr size_t WS_KC = 642 * MiB;
constexpr size_t WS_VC = 642 * MiB + 512 * 1024;
constexpr size_t WS_U = 643 * MiB;
constexpr size_t WS_GV = 675 * MiB;
constexpr size_t WS_O = 707 * MiB;
constexpr size_t WS_MIX = 771 * MiB;
constexpr size_t WS_ACT = 526 * MiB;
constexpr size_t WS_END = 835 * MiB;
static_assert(WS_ACT + (size_t)MAXTILES * 256 * FF * 2 <= WS_END, "act overlay");
static_assert(WS_H + (size_t)(TT + TC) * DM * 2 <= WS_Q, "h");

constexpr int CW_TMO = 0;
constexpr int CW_BAR = 4096;
constexpr int CW_CNT = 16384;

constexpr int RING_BYTES = 131072;
constexpr int MISC_OFF = RING_BYTES;
constexpr int LDS_BYTES = 147456;
constexpr int L_BARW = MISC_OFF + 32;
constexpr int L_XCH = MISC_OFF + 1024;
constexpr int L_TILEE = MISC_OFF + 6144;
constexpr int L_CNT = MISC_OFF + 7168;
constexpr int L_SEL = MISC_OFF + 8192;

#define RLX_AGENT __ATOMIC_RELAXED, __HIP_MEMORY_SCOPE_AGENT
#define LDS_WAIT() asm volatile("s_waitcnt lgkmcnt(0)" ::: "memory")
#define VM_WAIT() asm volatile("s_waitcnt vmcnt(0)" ::: "memory")
__device__ __forceinline__ unsigned f2bf(float f) { unsigned u = __builtin_bit_cast(unsigned, f); return (u + 0x7fffu + ((u >> 16) & 1u)) >> 16; }
__device__ __forceinline__ unsigned pk2(float lo, float hi) { return f2bf(lo) | (f2bf(hi) << 16); }
__device__ __forceinline__ unsigned cvt_pk_bf16(float lo, float hi) { unsigned r; asm volatile("v_cvt_pk_bf16_f32 %0, %1, %2" : "=v"(r) : "v"(lo), "v"(hi)); return r; }
__device__ __forceinline__ float clamp448(float v) { return __builtin_amdgcn_fmed3f(v, -448.0f, 448.0f); }
__device__ __forceinline__ unsigned pk4_fp8(float a, float b, float c, float d) {
    int r = __builtin_amdgcn_cvt_pk_fp8_f32(clamp448(a), clamp448(b), 0, false); r = __builtin_amdgcn_cvt_pk_fp8_f32(clamp448(c), clamp448(d), r, true); return (unsigned)r; }
__device__ __forceinline__ float bflo(unsigned u) { return __builtin_bit_cast(float, u << 16); }
__device__ __forceinline__ float bfhi(unsigned u) { return __builtin_bit_cast(float, u & 0xffff0000u); }
__device__ __forceinline__ float wave_sum(float v) {
#pragma unroll
    for (int o = 1; o < 64; o <<= 1) v += __shfl_xor(v, o);
    return v;
}
__device__ __forceinline__ float gelu_tanh(float x) {
    const float u = 0.7978845608028654f * (x + 0.044715f * x * x * x);
    return x * __builtin_amdgcn_rcpf(1.0f + __builtin_amdgcn_exp2f(-2.0f * LOG2E * u));
}

#define XB_TMO      128
#define XB_XCNT(j)  (256  + 64 * (j))
#define XB_XSUB(j)  (1280 + 64 * (j))
#define XB_XGEN(j)  (2304 + 64 * (j))
#define XB_TOP      3328
#define XB_TOPGEN   3392
#define XCD_BAR_WORDS 3456
#define XB_SPIN_CAP (1u << 18)
__device__ __forceinline__ unsigned xb_ld(unsigned* p)              { return __hip_atomic_load(p, __ATOMIC_RELAXED, __HIP_MEMORY_SCOPE_AGENT); }
__device__ __forceinline__ unsigned xb_add(unsigned* p, unsigned v) { return __hip_atomic_fetch_add(p, v, __ATOMIC_RELAXED, __HIP_MEMORY_SCOPE_AGENT); }
__device__ __forceinline__ unsigned xb_xcc_id() { return (unsigned)__builtin_amdgcn_s_getreg((3 << 11) | 20) & 0xFu; }
#define XB_SPIN(cond, bar) do { unsigned _sp = 0; while (cond) { __builtin_amdgcn_s_sleep(1); \
    if ((++_sp & 255u) == 0u) { if (xb_ld(&(bar)[XB_TMO])) break; if (_sp > XB_SPIN_CAP) { atomicAdd(&(bar)[XB_TMO], 1u); break; } } } } while (0)
struct XcdBarrier { unsigned* bar; unsigned x; volatile LAS unsigned* st; };
__device__ __forceinline__ XcdBarrier xcd_barrier_post(unsigned* bar, volatile LAS unsigned* st) {
    XcdBarrier b; b.bar = bar; b.x = xb_xcc_id(); b.st = st;
    if (threadIdx.x == 0) (void)xb_add(&bar[XB_XCNT(b.x)], 1u);
    return b;
}
__device__ __forceinline__ void xcd_barrier_complete(unsigned* bar, unsigned x, unsigned& nloc, unsigned& nx) {
    const unsigned G = gridDim.x * gridDim.y * gridDim.z;
    unsigned sum, cnt, mine, sp = 0u;
    for (;;) {
        sum = 0u; cnt = 0u; mine = 0u;
#pragma unroll
        for (unsigned j = 0; j < 16; ++j) { const unsigned c = xb_ld(&bar[XB_XCNT(j)]); sum += c; cnt += (c > 0u) ? 1u : 0u; mine = (j == x) ? c : mine; }
        if (sum == G) break;
        __builtin_amdgcn_s_sleep(1);
        if ((++sp & 255u) == 0u) { if (xb_ld(&bar[XB_TMO])) break; if (sp > XB_SPIN_CAP) { atomicAdd(&bar[XB_TMO], 1u); break; } }
    }
    nloc = mine > 0u ? mine : 1u; nx = cnt > 0u ? cnt : 1u;
}
__device__ __forceinline__ void xcd_barrier(const XcdBarrier& b) {
    asm volatile("s_waitcnt vmcnt(0)" ::: "memory");
    __syncthreads();
    if (threadIdx.x == 0) {
        unsigned* bar = b.bar;
        __builtin_amdgcn_s_waitcnt(0);
        unsigned nloc = b.st[0], nx = b.st[1];
        if (nloc == 0u) { xcd_barrier_complete(bar, b.x, nloc, nx); b.st[0] = nloc; b.st[1] = nx; }
        const unsigned old = xb_add(&bar[XB_XSUB(b.x)], 1u);
        const unsigned gen = old / nloc;
        if (old + 1u == (gen + 1u) * nloc) {
            __builtin_amdgcn_fence(__ATOMIC_RELEASE, "agent");
            asm volatile("s_waitcnt vmcnt(0)" ::: "memory");
            const unsigned og = xb_add(&bar[XB_TOP], 1u);
            const unsigned tg = og / nx;
            if (og + 1u == (tg + 1u) * nx) xb_add(&bar[XB_TOPGEN], 1u);
            else XB_SPIN(xb_ld(&bar[XB_TOPGEN]) == tg, bar);
            __builtin_amdgcn_fence(__ATOMIC_ACQUIRE, "agent");
            xb_add(&bar[XB_XGEN(b.x)], 1u);
            asm volatile("s_waitcnt vmcnt(0)" ::: "memory");
        } else {
            XB_SPIN(xb_ld(&bar[XB_XGEN(b.x)]) == gen, bar);
            __builtin_amdgcn_fence(__ATOMIC_ACQUIRE, "agent");
            asm volatile("s_waitcnt vmcnt(0)" ::: "memory");
        }
    }
    __syncthreads();
}

namespace pg8 {
constexpr int BM = 256, BK = 64, HALF = 128, HTB = HALF * BK * 2, STAGE_BYTES = 8 * HTB, NXCD = 8, WGM = 8;
__host__ __device__ __forceinline__ int lds_byte(int r, int c) { const int st = (r >> 4) * 2 + (c >> 5), rr = r & 15, cc = c & 31, ob = rr * 64 + cc * 2; return st * 1024 + (ob ^ (((ob >> 9) & 1) << 5)); }
__host__ __device__ __forceinline__ void stage_rc(int b, int& R, int& C) { const int st = b / 1024, sb = b % 1024, swz = sb ^ (((sb >> 9) & 1) << 5); R = (st >> 1) * 16 + swz / 64; C = (st & 1) * 32 + (swz % 64) / 2; }
__host__ __device__ __forceinline__ int perm32(int rho) { const int n = rho >> 4, i = rho & 15; return 8 * (i >> 2) + 4 * n + (i & 3); }

struct Unit { int pm, pn; int arow; size_t boff; int e, lt, nvalid; const int* gidx; };

__device__ __forceinline__ const char* uptr(const char* p) { const unsigned long long v = (unsigned long long)p;
    const unsigned lo = __builtin_amdgcn_readfirstlane((unsigned)v), hi = __builtin_amdgcn_readfirstlane((unsigned)(v >> 32)); return (const char*)(((unsigned long long)hi << 32) | lo); }
__device__ __forceinline__ void tile_order(int L, int nM, int nN, int& pm, int& pn) {
    const int nwg = nM * nN;
    int wgid = L; { const int q = nwg / NXCD, r = nwg % NXCD, xcd = wgid % NXCD, off = wgid / NXCD; wgid = (xcd < r ? xcd * (q + 1) : r * (q + 1) + (xcd - r) * q) + off; }
    const int nig = WGM * nN, gid = wgid / nig, fm = gid * WGM, gsz = (nM - fm) < WGM ? (nM - fm) : WGM;
    pm = fm + ((wgid % nig) % gsz); pn = (wgid % nig) / gsz;
}

#if !GEMM_NAIVE
template <class Epi, class Sched, int AMODE  , bool ALIGN_EPI, bool FP8 = false>
__device__ __forceinline__ void gemm_phase(LAS unsigned char* lds, const void* A, const void* Bt, const int K, const Sched& S, const Epi& E) {
    const int tid = threadIdx.x, wid = __builtin_amdgcn_readfirstlane(tid >> 6), lane = tid & 63, wr = wid >> 2, wc = wid & 3, fr = lane & 15, fq = lane >> 4;
    constexpr bool GATHER = AMODE != 0;
    const int rowb = K * (FP8 ? 1 : 2);
    const int nt = rowb / 128;
    unsigned voffA[2][2], voffB[2]; int Rr[2], Cc[2];
#pragma unroll
    for (int i = 0; i < 2; ++i) { int R, C; stage_rc(tid * 16 + i * 8192, R, C); Rr[i] = R; Cc[i] = C; const int Rb = Epi::PERM ? ((R & ~31) + perm32(R & 31)) : R;
        voffB[i] = (unsigned)(Rb * rowb + C * 2);
        voffA[0][i] = (unsigned)(R * rowb + C * 2); voffA[1][i] = (unsigned)((R + HALF) * rowb + C * 2); }
    const size_t kstep = (size_t)128;
    const size_t hstepB = (size_t)HALF * rowb;
    const unsigned ldsw = (unsigned)wid * 1024u;
    const int aoff = lds_byte(wr * 64 + fr, fq * 8), boff = lds_byte(wc * 32 + fr, fq * 8);
#define PG8_SA(b, h) (((b) * 2 + (h)) * HTB)
#define PG8_SB(b, h) ((4 + (b) * 2 + (h)) * HTB)
#define PG8_STAGE_A(bufoff, kb, h) do { _Pragma("unroll") for (int _i = 0; _i < 2; ++_i) \
        __builtin_amdgcn_global_load_lds((const unsigned*)((const char*)(kb) + (GATHER ? (size_t)0 : (size_t)(h) * hstepB) + voffA[GATHER ? (h) : 0][_i]), (LAS unsigned*)(lds + (bufoff) + ldsw + _i * 8192), 16, 0, 0); } while (0)
#define PG8_STAGE_B(bufoff, kb, h) do { _Pragma("unroll") for (int _i = 0; _i < 2; ++_i) \
        __builtin_amdgcn_global_load_lds((const unsigned*)((const char*)(kb) + (size_t)(h) * hstepB + voffB[_i]), (LAS unsigned*)(lds + (bufoff) + ldsw + _i * 8192), 16, 0, 0); } while (0)
#define PG8_LDA(dst, b, h) do { _Pragma("unroll") for (int m = 0; m < 4; ++m) dst[m] = PG8_CAT(*(const LAS v4i_t*)(lds + PG8_SA(b, h) + aoff + m * 2048), *(const LAS v4i_t*)(lds + PG8_SA(b, h) + aoff + m * 2048 + 1024)); } while (0)
#define PG8_LDB(dst, b, h) do { _Pragma("unroll") for (int n = 0; n < 2; ++n) dst[n] = PG8_CAT(*(const LAS v4i_t*)(lds + PG8_SB(b, h) + boff + n * 2048), *(const LAS v4i_t*)(lds + PG8_SB(b, h) + boff + n * 2048 + 1024)); } while (0)
#define PG8_MMA(ai, bj, At, Bt_) do { __builtin_amdgcn_s_setprio(1); if constexpr (FP8) { _Pragma("unroll") for (int m = 0; m < 4; ++m) _Pragma("unroll") for (int n = 0; n < 2; ++n) \
        acc[ai][bj][m][n] = __builtin_amdgcn_mfma_scale_f32_16x16x128_f8f6f4(Bt_[n], At[m], acc[ai][bj][m][n], 0, 0, 0, 0, 0, 0); } \
      else { _Pragma("unroll") for (int m = 0; m < 4; ++m) _Pragma("unroll") for (int n = 0; n < 2; ++n) { \
        acc[ai][bj][m][n] = __builtin_amdgcn_mfma_f32_16x16x32_bf16(PG8_LO(Bt_[n]), PG8_LO(At[m]), acc[ai][bj][m][n], 0, 0, 0); \
        acc[ai][bj][m][n] = __builtin_amdgcn_mfma_f32_16x16x32_bf16(PG8_HI(Bt_[n]), PG8_HI(At[m]), acc[ai][bj][m][n], 0, 0, 0); } } __builtin_amdgcn_s_setprio(0); } while (0)
#define PG8_LO(x) __builtin_bit_cast(bf16x8, __builtin_shufflevector(x, x, 0, 1, 2, 3))
#define PG8_HI(x) __builtin_bit_cast(bf16x8, __builtin_shufflevector(x, x, 4, 5, 6, 7))
#define PG8_CAT(x, y) __builtin_shufflevector(x, y, 0, 1, 2, 3, 4, 5, 6, 7)
#define PG8_WAIT_V(n) asm volatile("s_waitcnt vmcnt(" #n ")" ::: "memory")
#define PG8_WAIT_L(n) asm volatile("s_waitcnt lgkmcnt(" #n ")" ::: "memory")
#define PG8_BAR __builtin_amdgcn_s_barrier()
#define PG8_SCHED __builtin_amdgcn_sched_barrier(0)
#define PG8_GIDX(u, dst) do { _Pragma("unroll") for (int _h = 0; _h < 2; ++_h) _Pragma("unroll") for (int _i = 0; _i < 2; ++_i) { const int _row = _h * HALF + Rr[_i]; \
        int _tok; if constexpr (AMODE == 1) _tok = (_row < (u).nvalid) ? ((u).gidx[_row] >> 2) : 0; else _tok = (u).arow + _row; dst[_h][_i] = (unsigned)(_tok * rowb + Cc[_i] * 2); } } while (0)
    Unit cur, nxt; int ui = 0;
    if (!S.next(0, cur)) return;
    f32x4 acc[2][2][4][2];
#pragma unroll
    for (int a = 0; a < 2; ++a)
#pragma unroll
        for (int b = 0; b < 2; ++b)
#pragma unroll
            for (int m = 0; m < 4; ++m)
#pragma unroll
                for (int n = 0; n < 2; ++n) acc[a][b][m][n] = (f32x4){0.f, 0.f, 0.f, 0.f};
    v8i_t At[4], B0[2], B1[2];
    unsigned voffN[2][2] = {{0u, 0u}, {0u, 0u}};
    if constexpr (GATHER) { PG8_GIDX(cur, voffA); }
    const char* cA = uptr(GATHER ? (const char*)A : (const char*)A + (size_t)cur.arow * rowb); const char* cB = uptr((const char*)Bt + cur.boff);
    PG8_STAGE_B(PG8_SB(0, 0), cB, 0); PG8_STAGE_B(PG8_SB(0, 1), cB, 1); PG8_STAGE_A(PG8_SA(0, 0), cA, 0); PG8_STAGE_A(PG8_SA(0, 1), cA, 1);
    if (wr == 1) PG8_BAR;
    PG8_WAIT_V(2); PG8_BAR;
    PG8_STAGE_B(PG8_SB(1, 0), cB + kstep, 0); PG8_STAGE_A(PG8_SA(1, 0), cA + kstep, 0); PG8_STAGE_B(PG8_SB(1, 1), cB + kstep, 1);
    PG8_WAIT_V(6); PG8_BAR;
    for (;;) {
        const bool has_next = S.next(ui + 1, nxt);
        if constexpr (GATHER) { if (has_next) { PG8_GIDX(nxt, voffN); } }
        const char* nA = uptr(has_next ? (GATHER ? (const char*)A : (const char*)A + (size_t)nxt.arow * rowb) : cA); const char* nB = uptr(has_next ? (const char*)Bt + nxt.boff : cB);
#pragma unroll 1
        for (int t = 0; t < nt; t += 2) {
            const bool last = (t == nt - 2);
            const char* a1 = cA + (size_t)(t + 1) * kstep;
            const char* a2 = last ? nA : cA + (size_t)(t + 2) * kstep; const char* b2 = last ? nB : cB + (size_t)(t + 2) * kstep;
            const char* a3 = a2 + kstep; const char* b3 = b2 + kstep;
            PG8_LDB(B0, 0, 0); PG8_LDB(B1, 0, 1); PG8_SCHED; PG8_LDA(At, 0, 0); PG8_STAGE_A(PG8_SA(1, 1), a1, 1);
            if constexpr (GATHER) { if (last && has_next) {
#pragma unroll
                for (int h = 0; h < 2; ++h)
#pragma unroll
                    for (int i = 0; i < 2; ++i) voffA[h][i] = voffN[h][i]; } }
            PG8_WAIT_V(8); PG8_WAIT_L(0); PG8_BAR; PG8_MMA(0, 0, At, B0); PG8_MMA(0, 1, At, B1); PG8_BAR; PG8_SCHED;
            PG8_LDA(At, 0, 1); PG8_STAGE_B(PG8_SB(0, 0), b2, 0); PG8_STAGE_B(PG8_SB(0, 1), b2, 1); PG8_STAGE_A(PG8_SA(0, 0), a2, 0);
            PG8_WAIT_V(8); PG8_WAIT_L(0); PG8_BAR; PG8_MMA(1, 0, At, B0); PG8_MMA(1, 1, At, B1); PG8_BAR; PG8_SCHED;
            PG8_LDB(B0, 1, 0); PG8_LDB(B1, 1, 1); PG8_SCHED; PG8_LDA(At, 1, 0); PG8_STAGE_A(PG8_SA(0, 1), a2, 1);
            PG8_WAIT_V(8); PG8_WAIT_L(0); PG8_BAR; PG8_MMA(0, 0, At, B0); PG8_MMA(0, 1, At, B1); PG8_BAR; PG8_SCHED;
            PG8_LDA(At, 1, 1); PG8_STAGE_B(PG8_SB(1, 0), b3, 0); PG8_STAGE_B(PG8_SB(1, 1), b3, 1); PG8_STAGE_A(PG8_SA(1, 0), a3, 0);
            PG8_WAIT_V(8); PG8_WAIT_L(0); PG8_BAR; PG8_MMA(1, 0, At, B0); PG8_MMA(1, 1, At, B1); PG8_BAR; PG8_SCHED;
        }
        if constexpr (ALIGN_EPI) { if (wr == 0) PG8_BAR; }
        E(acc, cur, wr, wc, fr, fq);
        if (!has_next) break;
#pragma unroll
        for (int a = 0; a < 2; ++a)
#pragma unroll
            for (int b = 0; b < 2; ++b)
#pragma unroll
                for (int m = 0; m < 4; ++m)
#pragma unroll
                    for (int n = 0; n < 2; ++n) acc[a][b][m][n] = (f32x4){0.f, 0.f, 0.f, 0.f};
        cur = nxt; cA = nA; cB = nB; ++ui;
        if constexpr (ALIGN_EPI) { if (wr == 1) PG8_BAR; }
    }
    PG8_WAIT_V(0);
    if constexpr (!ALIGN_EPI) { if (wr == 0) PG8_BAR; }
    PG8_BAR;
#undef PG8_SA
#undef PG8_SB
#undef PG8_STAGE_A
#undef PG8_STAGE_B
#undef PG8_LDA
#undef PG8_LDB
#undef PG8_MMA
#undef PG8_CAT
#undef PG8_LO
#undef PG8_HI
#undef PG8_WAIT_V
#undef PG8_WAIT_L
#undef PG8_BAR
#undef PG8_SCHED
#undef PG8_GIDX
}
#else
template <class Epi, class Sched, int AMODE, bool ALIGN_EPI, bool FP8 = false>
__device__ __forceinline__ void gemm_phase(LAS unsigned char* lds, const void* A_, const void* Bt, const int K, const Sched& S, const Epi& E) {
    static_assert(!FP8, "the debug GEMM is bf16 only"); const bf16* A = (const bf16*)A_; constexpr bool GATHER = AMODE == 1;
    const int tid = threadIdx.x, wid = __builtin_amdgcn_readfirstlane(tid >> 6), lane = tid & 63, wr = wid >> 2, wc = wid & 3, fr = lane & 15, fq = lane >> 4;
    constexpr int PITCH = 66;
    LAS bf16* As = (LAS bf16*)lds; LAS bf16* Bs = (LAS bf16*)(lds + 256 * PITCH * 2);
    Unit u;
    for (int ui = 0; S.next(ui, u); ++ui) {
        f32x4 acc[2][2][4][2];
#pragma unroll
        for (int a = 0; a < 2; ++a)
#pragma unroll
            for (int b = 0; b < 2; ++b)
#pragma unroll
                for (int m = 0; m < 4; ++m)
#pragma unroll
                    for (int n = 0; n < 2; ++n) acc[a][b][m][n] = (f32x4){0.f, 0.f, 0.f, 0.f};
        for (int kt = 0; kt < K; kt += 64) {
            __syncthreads();
            for (int q = tid; q < 2048; q += 512) { const int row = q >> 3, c8 = (q & 7) * 8;
                int arow; if (GATHER) arow = (row < u.nvalid) ? (u.gidx[row] >> 2) : 0; else arow = u.arow + row;
                const v4u va = *(const v4u*)(A + (size_t)arow * K + kt + c8);
                LAS unsigned* da = (LAS unsigned*)(As + row * PITCH + c8); da[0] = va.x; da[1] = va.y; da[2] = va.z; da[3] = va.w;
                const v4u vb = *(const v4u*)((const char*)Bt + u.boff + ((size_t)row * K + kt + c8) * 2);
                LAS unsigned* db = (LAS unsigned*)(Bs + row * PITCH + c8); db[0] = vb.x; db[1] = vb.y; db[2] = vb.z; db[3] = vb.w; }
            __syncthreads();
            for (int k = 0; k < 64; ++k) {
                float av[2][4], bv[2][2][4];
#pragma unroll
                for (int ai = 0; ai < 2; ++ai)
#pragma unroll
                    for (int m = 0; m < 4; ++m) av[ai][m] = bflo((unsigned)As[(ai * 128 + wr * 64 + m * 16 + fr) * PITCH + k]);
#pragma unroll
                for (int bj = 0; bj < 2; ++bj)
#pragma unroll
                    for (int n = 0; n < 2; ++n)
#pragma unroll
                        for (int j = 0; j < 4; ++j) { const int col = bj * 128 + wc * 32 + (Epi::PERM ? (8 * fq + 4 * n + j) : (16 * n + 4 * fq + j)); bv[bj][n][j] = bflo((unsigned)Bs[col * PITCH + k]); }
#pragma unroll
                for (int ai = 0; ai < 2; ++ai)
#pragma unroll
                    for (int bj = 0; bj < 2; ++bj)
#pragma unroll
                        for (int m = 0; m < 4; ++m)
#pragma unroll
                            for (int n = 0; n < 2; ++n)
#pragma unroll
                                for (int j = 0; j < 4; ++j) acc[ai][bj][m][n][j] += av[ai][m] * bv[bj][n][j];
            }
        }
        E(acc, u, wr, wc, fr, fq);
    }
    __syncthreads();
}
#endif

struct SchedIn {
    int G, c;
    __device__ __forceinline__ bool next(int i, Unit& u) const {
        const int L = i * G + c; constexpr int NL = 128 * 7;
        if (L >= NL + 8) return false;
        if (L < NL) tile_order(L, 128, 7, u.pm, u.pn); else { u.pm = 128 + (L - NL); u.pn = 2; }
        u.arow = u.pm * 256; u.boff = (size_t)u.pn * 256 * DM * 2; u.e = 0; u.lt = 0; u.nvalid = 256; u.gidx = nullptr; return true;
    }
};
struct SchedOut {
    int G, c;
    __device__ __forceinline__ bool next(int i, Unit& u) const {
        const int L = i * G + c; if (L >= 128 * 4) return false;
        tile_order(L, 128, 4, u.pm, u.pn);
        u.arow = u.pm * 256; u.boff = (size_t)u.pn * 256 * DM * 2; u.e = 0; u.lt = 0; u.nvalid = 256; u.gidx = nullptr; return true;
    }
};
template <int NN, int ESZ> struct SchedMoe {
    int G, c; const LAS unsigned char* tile_e; const LAS int* tab; const int* rowdst;
    __device__ __forceinline__ bool next(int i, Unit& u) const {
        const int ntiles = __builtin_amdgcn_readfirstlane(tab[65]); const int L = i * G + c; if (L >= ntiles * NN) return false;
        tile_order(L, ntiles, NN, u.pm, u.pn);
        const int e = __builtin_amdgcn_readfirstlane((int)tile_e[u.pm]); u.e = e; u.lt = u.pm - __builtin_amdgcn_readfirstlane(tab[32 + e]);
        const int rem = __builtin_amdgcn_readfirstlane(tab[e]) - u.lt * 256; u.nvalid = rem < 256 ? rem : 256;
        u.gidx = rowdst + (size_t)e * ECAP + u.lt * 256;
        u.arow = u.pm * 256; u.boff = ((size_t)e * NN * 256 + (size_t)u.pn * 256) * DM * ESZ; return true;
    }
};

struct EpiInProj {
    static constexpr bool PERM = true;
    const float* bias; bf16 *Q, *Kx, *V, *KC, *VC, *U, *GV; const float* rope;
    __device__ __forceinline__ void operator()(const f32x4 (&acc)[2][2][4][2], const Unit& u, int wr, int wc, int fr, int fq) const {
        const int row0 = u.pm * BM + wr * 64 + fr, colt = wc * 32 + 8 * fq, pn = u.pn;
        f32x4 bv[2][2];
#pragma unroll
        for (int bj = 0; bj < 2; ++bj)
#pragma unroll
            for (int n = 0; n < 2; ++n) bv[bj][n] = *(const f32x4*)(bias + pn * 256 + bj * HALF + colt + 4 * n);
        if (pn <= 2) {
            const bool ctxrow = u.pm >= 128; const bool upper = (fq >> 1) != 0;
#pragma unroll
            for (int ai = 0; ai < 2; ++ai)
#pragma unroll
                for (int m = 0; m < 4; ++m) {
                    const int row = row0 + ai * HALF + m * 16; const int t = row & (SEQ - 1); const int pos = (wc & 1) ? (t & 63) : (t >> 6);
                    const f32x4 c0 = *(const f32x4*)(rope + pos * 16 + 8 * (fq & 1)), c1 = *(const f32x4*)(rope + pos * 16 + 8 * (fq & 1) + 4);
                    const f32x4 s0 = *(const f32x4*)(rope + 1024 + pos * 16 + 8 * (fq & 1)), s1 = *(const f32x4*)(rope + 1024 + pos * 16 + 8 * (fq & 1) + 4);
#pragma unroll
                    for (int bj = 0; bj < 2; ++bj) {
                        const bool dorope = (pn < 2) || (bj == 0 && !ctxrow);
                        const f32x4 vin0 = acc[ai][bj][m][0] + bv[bj][0], vin1 = acc[ai][bj][m][1] + bv[bj][1];
                        f32x4 v[2]; v[0] = vin0; v[1] = vin1;
                        if (dorope) {
                            float ro[2][4];
#pragma unroll
                            for (int n = 0; n < 2; ++n)
#pragma unroll
                                for (int j = 0; j < 4; ++j) {
                                    const float xin = n ? vin1[j] : vin0[j];
                                    const unsigned xb = __builtin_bit_cast(unsigned, xin);
                                    auto rr = __builtin_amdgcn_permlane32_swap(xb, xb, false, false);
                                    const float x1 = __builtin_bit_cast(float, (unsigned)rr[0]), x2 = __builtin_bit_cast(float, (unsigned)rr[1]);
                                    const float cs = n ? c1[j] : c0[j], sn = n ? s1[j] : s0[j];
                                    ro[n][j] = upper ? (x2 * cs + x1 * sn) : (x1 * cs - x2 * sn);
                                }
                            v[0] = (f32x4){ro[0][0], ro[0][1], ro[0][2], ro[0][3]}; v[1] = (f32x4){ro[1][0], ro[1][1], ro[1][2], ro[1][3]};
                        }
                        if (pn < 2) { v[0] = v[0] * QSCALE; v[1] = v[1] * QSCALE; }
                        v4u w; w.x = cvt_pk_bf16(v[0][0], v[0][1]); w.y = cvt_pk_bf16(v[0][2], v[0][3]); w.z = cvt_pk_bf16(v[1][0], v[1][1]); w.w = cvt_pk_bf16(v[1][2], v[1][3]);
                        bf16* dst;
                        if (pn < 2) dst = Q + (size_t)row * 512 + pn * 256 + bj * HALF + colt;
                        else if (!ctxrow) dst = (bj == 0 ? Kx : V) + (size_t)row * 128 + colt;
                        else dst = (bj == 0 ? KC : VC) + (size_t)(row - TT) * 128 + colt;
                        *(v4u*)dst = w;
                    }
                }
        } else {
            bf16* base = (pn < 5 ? U : GV) + ((pn - 3) & 1) * 256 + colt;
#pragma unroll
            for (int ai = 0; ai < 2; ++ai)
#pragma unroll
                for (int m = 0; m < 4; ++m) { const int row = row0 + ai * HALF + m * 16;
#pragma unroll
                    for (int bj = 0; bj < 2; ++bj) { f32x4 v0 = acc[ai][bj][m][0] + bv[bj][0], v1 = acc[ai][bj][m][1] + bv[bj][1];
#pragma unroll
                        for (int j = 0; j < 4; ++j) { v0[j] = gelu_tanh(v0[j]); v1[j] = gelu_tanh(v1[j]); }
                        v4u w; w.x = cvt_pk_bf16(v0[0], v0[1]); w.y = cvt_pk_bf16(v0[2], v0[3]); w.z = cvt_pk_bf16(v1[0], v1[1]); w.w = cvt_pk_bf16(v1[2], v1[3]);
                        *(v4u*)(base + (size_t)row * 512 + bj * HALF) = w; } }
        }
    }
};
struct EpiOut {
    static constexpr bool PERM = true;
    const float* bias; bf16* O;
    __device__ __forceinline__ void operator()(const f32x4 (&acc)[2][2][4][2], const Unit& u, int wr, int wc, int fr, int fq) const {
        const int row0 = u.pm * BM + wr * 64 + fr, col0 = u.pn * BM + wc * 32 + 8 * fq;
        f32x4 bv[2][2];
#pragma unroll
        for (int bj = 0; bj < 2; ++bj)
#pragma unroll
            for (int n = 0; n < 2; ++n) bv[bj][n] = *(const f32x4*)(bias + col0 + bj * HALF + 4 * n);
#pragma unroll
        for (int ai = 0; ai < 2; ++ai)
#pragma unroll
            for (int m = 0; m < 4; ++m) { bf16* rowp = O + (size_t)(row0 + ai * HALF + m * 16) * DM + col0;
#pragma unroll
                for (int bj = 0; bj < 2; ++bj) { const f32x4 v0 = acc[ai][bj][m][0] + bv[bj][0], v1 = acc[ai][bj][m][1] + bv[bj][1];
                    v4u w; w.x = cvt_pk_bf16(v0[0], v0[1]); w.y = cvt_pk_bf16(v0[2], v0[3]); w.z = cvt_pk_bf16(v1[0], v1[1]); w.w = cvt_pk_bf16(v1[2], v1[3]);
                    *(v4u*)(rowp + bj * HALF) = w; } }
    }
};
struct EpiSwiglu {
    static constexpr bool PERM = true;
    const float* bgu; unsigned char* ACT;
    __device__ __forceinline__ void operator()(const f32x4 (&acc)[2][2][4][2], const Unit& u, int wr, int wc, int fr, int fq) const {
        asm volatile("" : "+v"(fr), "+v"(fq));
        const int row0 = u.pm * BM + wr * 64 + fr, colt = u.pn * HALF + wc * 32 + 8 * fq;
        const float* bg = bgu + (size_t)u.e * 2048 + colt;
        f32x4 bgv[2], buv[2];
#pragma unroll
        for (int n = 0; n < 2; ++n) { bgv[n] = *(const f32x4*)(bg + 4 * n); buv[n] = *(const f32x4*)(bg + 1024 + 4 * n); }
#pragma unroll
        for (int ai = 0; ai < 2; ++ai)
#pragma unroll
            for (int m = 0; m < 4; ++m) { f32x4 o[2];
#pragma unroll
                for (int n = 0; n < 2; ++n) { const f32x4 g4 = acc[ai][0][m][n] * DQ1 + bgv[n], u4 = acc[ai][1][m][n] * DQ1 + buv[n];
#pragma unroll
                    for (int j = 0; j < 4; ++j) { const float g = fminf(g4[j], 7.0f), up = fminf(fmaxf(u4[j], -7.0f), 7.0f);
                        o[n][j] = ACT_SCALE * (up + 1.0f) * g * __builtin_amdgcn_rcpf(1.0f + __builtin_amdgcn_exp2f(-1.702f * LOG2E * g)); } }
                v2u w; w.x = pk4_fp8(o[0][0], o[0][1], o[0][2], o[0][3]); w.y = pk4_fp8(o[1][0], o[1][1], o[1][2], o[1][3]);
                *(v2u*)(ACT + (size_t)(row0 + ai * HALF + m * 16) * FF + colt) = w; }
    }
};
struct EpiDown {
    static constexpr bool PERM = true;
    const float* bd; bf16* Y4;
    __device__ __forceinline__ void operator()(const f32x4 (&acc)[2][2][4][2], const Unit& u, int wr, int wc, int fr, int fq) const {
        asm volatile("" : "+v"(fr), "+v"(fq));
        const int rl0 = wr * 64 + fr, col0 = u.pn * BM + wc * 32 + 8 * fq;
        const float* bp = bd + (size_t)u.e * DM + col0;
        f32x4 bv[2][2];
#pragma unroll
        for (int bj = 0; bj < 2; ++bj)
#pragma unroll
            for (int n = 0; n < 2; ++n) bv[bj][n] = *(const f32x4*)(bp + bj * HALF + 4 * n);
#pragma unroll
        for (int ai = 0; ai < 2; ++ai)
#pragma unroll
            for (int m = 0; m < 4; ++m) { const int rl = rl0 + ai * HALF + m * 16;
                if (rl < u.nvalid) { const int dst = u.gidx[rl]; bf16* rowp = Y4 + (size_t)dst * DM + col0;
#pragma unroll
                    for (int bj = 0; bj < 2; ++bj) { const f32x4 v0 = acc[ai][bj][m][0] * DQ2 + bv[bj][0], v1 = acc[ai][bj][m][1] * DQ2 + bv[bj][1];
                        v4u w; w.x = cvt_pk_bf16(v0[0], v0[1]); w.y = cvt_pk_bf16(v0[2], v0[3]); w.z = cvt_pk_bf16(v1[0], v1[1]); w.w = cvt_pk_bf16(v1[2], v1[3]);
                        *(v4u*)(rowp + bj * HALF) = w; } } }
    }
};
}

constexpr int NWAVES = 8;
struct Frame {
    LAS unsigned char* lds;
    gu32* ctl;
    int tid, lane, wave;
    int vcu, G;
    const float* in[27]; float* out; unsigned char* ws;
};

__device__ __forceinline__ void p0_transpose_item(const float* W, int K, int N, bf16* WT, int drow0, int k0, int n0, LAS float* scr, int lane) {
#pragma unroll 8
    for (int i = 0; i < 32; ++i) { const int kk = 2 * i + (lane >> 5); scr[kk * 33 + (lane & 31)] = W[(size_t)(k0 + kk) * N + n0 + (lane & 31)]; }
    LDS_WAIT(); asm volatile("" ::: "memory");
    const int c = lane & 7;
#pragma unroll
    for (int j = 0; j < 4; ++j) { const int n = (lane >> 3) + 8 * j; const LAS float* s = scr + (8 * c) * 33 + n;
        v4u o; o.x = pk2(s[0 * 33], s[1 * 33]); o.y = pk2(s[2 * 33], s[3 * 33]); o.z = pk2(s[4 * 33], s[5 * 33]); o.w = pk2(s[6 * 33], s[7 * 33]);
        *(GAS v4u*)(WT + (size_t)(drow0 + n) * K + k0 + 8 * c) = o; }
    LDS_WAIT(); asm volatile("" ::: "memory");
}
__device__ __forceinline__ void p0_transpose_item_fp8(const float* W, int K, int N, unsigned char* WT, int drow0, int k0, int n0, LAS float* scr, int lane) {
#pragma unroll 8
    for (int i = 0; i < 32; ++i) { const int kk = 2 * i + (lane >> 5); scr[kk * 33 + (lane & 31)] = W[(size_t)(k0 + kk) * N + n0 + (lane & 31)]; }
    LDS_WAIT(); asm volatile("" ::: "memory");
#pragma unroll
    for (int p = 0; p < 2; ++p) { const int ch = lane + 64 * p, n = ch >> 2, c = ch & 3; const LAS float* s = scr + (16 * c) * 33 + n;
        v4u o;
        o.x = pk4_fp8(s[0 * 33] * W_SCALE, s[1 * 33] * W_SCALE, s[2 * 33] * W_SCALE, s[3 * 33] * W_SCALE); o.y = pk4_fp8(s[4 * 33] * W_SCALE, s[5 * 33] * W_SCALE, s[6 * 33] * W_SCALE, s[7 * 33] * W_SCALE);
        o.z = pk4_fp8(s[8 * 33] * W_SCALE, s[9 * 33] * W_SCALE, s[10 * 33] * W_SCALE, s[11 * 33] * W_SCALE); o.w = pk4_fp8(s[12 * 33] * W_SCALE, s[13 * 33] * W_SCALE, s[14 * 33] * W_SCALE, s[15 * 33] * W_SCALE);
        *(GAS v4u*)(WT + (size_t)(drow0 + n) * K + k0 + 16 * c) = o; }
    LDS_WAIT(); asm volatile("" ::: "memory");
}
__device__ __forceinline__ void p0_prologue(Frame& F) {
    const float* c = F.in[1]; const float* c_ctx = F.in[3]; const float* w_ada = F.in[4]; const float* b_ada = F.in[5];
    float* MOD = (float*)(F.ws + WS_MOD);
    if ((int)blockIdx.x < NMOD / 32) {
        LAS float* sl = (LAS float*)F.lds;
        LAS float* red = (LAS float*)(F.lds + 9 * 1024 * 4);
        for (int q = F.tid; q < 9 * 1024; q += NWAVES * 64) { const float v = q < 8192 ? c[q] : c_ctx[q - 8192]; sl[q] = v / (1.0f + __expf(-v)); }
        __syncthreads();
        for (int item = blockIdx.x; item < NMOD / 32; item += F.G) {
            const int n0 = item * 32, col = F.lane & 31, kp = F.lane >> 5;
            float a[9];
#pragma unroll
            for (int r = 0; r < 9; ++r) a[r] = 0.f;
#pragma unroll 8
            for (int kk = 0; kk < 64; ++kk) { const int k = F.wave * 128 + 2 * kk + kp; const float wv = w_ada[(size_t)k * NMOD + n0 + col];
#pragma unroll
                for (int r = 0; r < 9; ++r) a[r] += sl[r * 1024 + k] * wv; }
#pragma unroll
            for (int r = 0; r < 9; ++r) { a[r] += __shfl_xor(a[r], 32); if (F.lane < 32) red[(F.wave * 9 + r) * 32 + col] = a[r]; }
            __syncthreads();
            if (F.tid < 9 * 32) { const int r = F.tid >> 5, cc = F.tid & 31; float s = b_ada[n0 + cc];
#pragma unroll
                for (int w = 0; w < 8; ++w) s += red[(w * 9 + r) * 32 + cc];
                MOD[r * NMOD + n0 + cc] = s; }
            __syncthreads();
        }
    }
    __syncthreads();
    if ((int)blockIdx.x == F.G - 1) {
        float* rope = (float*)(F.ws + WS_ROPE);
        for (int q = F.tid; q < 1024; q += NWAVES * 64) { const int pos = q >> 4, f = q & 15;
            const float inv = __builtin_amdgcn_exp2f(-(float)f * (13.287712379549449f / 16.0f));
            const float ang = (float)pos * inv; rope[q] = __cosf(ang); rope[1024 + q] = __sinf(ang); }
    }
    { const float* sw = F.in[15]; bf16* so = (bf16*)(F.ws + WS_SGUW);
      for (int q = blockIdx.x * NWAVES * 64 + F.tid; q < 8 * 128 * 128 / 4; q += F.G * NWAVES * 64) { const f32x4 v = *(const f32x4*)(sw + 4 * q); v2u o; o.x = pk2(v[0], v[1]); o.y = pk2(v[2], v[3]); *(v2u*)(so + 4 * q) = o; } }
    LAS float* scr = (LAS float*)(F.lds + F.wave * 16384);
    const int gw = F.vcu * NWAVES + F.wave, NGW = F.G * NWAVES;
    constexpr int I_IN = 16 * (NIN / 32), I_OUT = 16 * (DM / 32), I_GU = 16 * (2048 / 32), I_D = 16 * (DM / 32);
    constexpr int NITEMS = I_IN + I_OUT + NE * I_GU + NE * I_D;
    bf16* win = (bf16*)(F.ws + WS_WIN); bf16* wout = (bf16*)(F.ws + WS_WOUT); unsigned char* wgu = F.ws + WS_WGU; unsigned char* wd = F.ws + WS_WD;
    for (int it = gw; it < NITEMS; it += NGW) {
        int r = it;
        if (r < I_IN) { const int nb = NIN / 32; p0_transpose_item(F.in[10], DM, NIN, win, 32 * (r % nb), 64 * (r / nb), 32 * (r % nb), scr, F.lane); continue; } r -= I_IN;
        if (r < I_OUT) { const int nb = DM / 32; p0_transpose_item(F.in[19], DM, DM, wout, 32 * (r % nb), 64 * (r / nb), 32 * (r % nb), scr, F.lane); continue; } r -= I_OUT;
        if (r < NE * I_GU) { const int e = r / I_GU, q = r % I_GU, nb = 2048 / 32, n0 = 32 * (q % nb), k0 = 64 * (q / nb);
            const int drow = n0 < 1024 ? (n0 >> 7) * 256 + (n0 & 127) : ((n0 - 1024) >> 7) * 256 + 128 + ((n0 - 1024) & 127);
            p0_transpose_item_fp8(F.in[23] + (size_t)e * DM * 2048, DM, 2048, wgu + (size_t)e * 2048 * DM, drow, k0, n0, scr, F.lane); continue; } r -= NE * I_GU;
        { const int e = r / I_D, q = r % I_D, nb = DM / 32, n0 = 32 * (q % nb), k0 = 64 * (q / nb);
            p0_transpose_item_fp8(F.in[25] + (size_t)e * FF * DM, FF, DM, wd + (size_t)e * DM * FF, n0, k0, n0, scr, F.lane); }
    }
}

__device__ __forceinline__ void p1_prenorm(Frame& F) {
    const float* MOD = (const float*)(F.ws + WS_MOD); const float* g = F.in[6]; bf16* H = (bf16*)(F.ws + WS_H);
    const int gw = F.vcu * NWAVES + F.wave, NGW = F.G * NWAVES, lane = F.lane;
    constexpr int RPW = 17;
    for (int m0 = gw * RPW; m0 < TT + TC; m0 += NGW * RPW) {
        f32x4 a1[4], a2[4]; int curb = -1;
        f32x4 xn[4];
#define P1_LOAD(m_) do { const float* xrow_ = (m_) < TT ? F.in[0] + (size_t)(m_) * DM : F.in[2] + (size_t)((m_) - TT) * DM; const GAS f32x4* xr_ = (const GAS f32x4*)xrow_ + lane; \
            _Pragma("unroll") for (int j = 0; j < 4; ++j) xn[j] = xr_[64 * j]; } while (0)
        P1_LOAD(m0);
#pragma unroll 1
        for (int r = 0; r < RPW; ++r) {
            const int m = m0 + r; if (m >= TT + TC) break;
            const int bb = m < TT ? (m >> 12) : 8;
            if (bb != curb) { curb = bb; const float* md = MOD + bb * NMOD;
#pragma unroll
                for (int j = 0; j < 4; ++j) { const int col = 4 * lane + 256 * j; a1[j] = *(const f32x4*)(g + col) * (*(const f32x4*)(md + DM + col) + 1.0f); a2[j] = *(const f32x4*)(md + col); } }
            f32x4 v[4]; float s = 0.f;
#pragma unroll
            for (int j = 0; j < 4; ++j) { v[j] = xn[j]; s += (v[j].x * v[j].x + v[j].y * v[j].y) + (v[j].z * v[j].z + v[j].w * v[j].w); }
            if (r + 1 < RPW && m + 1 < TT + TC) P1_LOAD(m + 1);
            const float rstd = 1.0f / sqrtf(wave_sum(s) * (1.0f / DM) + EPS);
            GAS v2u* o8 = (GAS v2u*)(H + (size_t)m * DM) + lane;
#pragma unroll
            for (int j = 0; j < 4; ++j) { const f32x4 y = v[j] * rstd * a1[j] + a2[j]; v2u o; o.x = pk2(y.x, y.y); o.y = pk2(y.z, y.w); o8[64 * j] = o; }
        }
#undef P1_LOAD
    }
}

__device__ __forceinline__ int crow(int r, int hi) { return (r & 3) + 8 * (r >> 2) + 4 * hi; }
typedef short v4i16_t __attribute__((ext_vector_type(4)));
__device__ __forceinline__ s16x4 vtr(const LAS unsigned char* p) { return __builtin_bit_cast(s16x4, __builtin_amdgcn_ds_read_tr16_b64_v4i16((LAS v4i16_t*)p)); }
__device__ __forceinline__ float swapsum(float v) { auto rr = __builtin_amdgcn_permlane32_swap(__builtin_bit_cast(unsigned, v), __builtin_bit_cast(unsigned, v), false, false); return __builtin_bit_cast(float, (unsigned)rr[0]) + __builtin_bit_cast(float, (unsigned)rr[1]); }
__device__ __forceinline__ float swapmax(float v) { auto rr = __builtin_amdgcn_permlane32_swap(__builtin_bit_cast(unsigned, v), __builtin_bit_cast(unsigned, v), false, false); return fmaxf(__builtin_bit_cast(float, (unsigned)rr[0]), __builtin_bit_cast(float, (unsigned)rr[1])); }

__device__ __forceinline__ void attn_unit(Frame& F, int b, int pb) {
    const bf16* Q = (const bf16*)(F.ws + WS_Q); const bf16* Kx = (const bf16*)(F.ws + WS_K); const bf16* Vx = (const bf16*)(F.ws + WS_V);
    const bf16* KC = (const bf16*)(F.ws + WS_KC); const bf16* VC = (const bf16*)(F.ws + WS_VC); bf16* O = (bf16*)(F.ws + WS_O);
    const float* sink = F.in[12]; const float* g_attn = F.in[17];
    const int lane = F.lane, r32 = lane & 31, hi = lane >> 5, wid = F.wave, hq = wid, kvh = wid >> 2;
    const int p0 = pb * 32, rowbase = b * SEQ;
    LAS unsigned char* lds = F.lds;
    LAS float* xch = (LAS float*)(F.lds + L_XCH);
    bf16x8 qr[4];
    { const bf16* qp = Q + (size_t)(rowbase + p0 + r32) * 512 + hq * 64 + hi * 8;
#pragma unroll
      for (int d0 = 0; d0 < 4; ++d0) qr[d0] = *(const bf16x8*)(qp + d0 * 16); }
    const int tlo = (p0 < 65) ? (p0 == 0 ? 2 : 1) : 0;
    const int thi = (p0 >= SEQ - 64) ? 2 : ((p0 >= SEQ - 128) ? 3 : 4);
    const int nb = thi - tlo + 1, ntile = nb + 4;
    v4u kreg[2], vreg[2];
#define ATT_LOAD_TILE(s_) do { const bf16 *kb_, *vb_; int krow_, vrow_; \
        if ((s_) < nb) { const int kp0_ = p0 - 128 + 64 * (tlo + (s_)); int kr_ = kp0_ + lane; kr_ = kr_ < 0 ? 0 : (kr_ > SEQ - 1 ? SEQ - 1 : kr_); \
            int vr_ = kp0_ + 16 * (wid & 3) + (lane >> 2); vr_ = vr_ < 0 ? 0 : (vr_ > SEQ - 1 ? SEQ - 1 : vr_); \
            kb_ = Kx + (size_t)rowbase * 128; vb_ = Vx + (size_t)rowbase * 128; krow_ = kr_; vrow_ = vr_; } \
        else { const int c0_ = 64 * ((s_) - nb); kb_ = KC + (size_t)b * LC * 128; vb_ = VC + (size_t)b * LC * 128; krow_ = c0_ + lane; vrow_ = c0_ + 16 * (wid & 3) + (lane >> 2); } \
        _Pragma("unroll") for (int i_ = 0; i_ < 2; ++i_) { kreg[i_] = *(const v4u*)(kb_ + (size_t)krow_ * 128 + i_ * 64 + 8 * wid); \
            vreg[i_] = *(const v4u*)(vb_ + (size_t)vrow_ * 128 + i_ * 64 + (wid >> 2) * 32 + (lane & 3) * 8); } } while (0)
#define ATT_WRITE_TILE(buf_) do { _Pragma("unroll") for (int i_ = 0; i_ < 2; ++i_) { *(LAS v4u*)(lds + (buf_) * 32768 + i_ * 8192 + wid * 1024 + lane * 16) = kreg[i_]; \
            *(LAS v4u*)(lds + (buf_) * 32768 + 16384 + i_ * 8192 + wid * 1024 + lane * 16) = vreg[i_]; } } while (0)
    ATT_LOAD_TILE(0); ATT_WRITE_TILE(0);
    float mrun = -INFINITY, lrun = 0.f; f32x16 o[2];
#pragma unroll
    for (int r = 0; r < 16; ++r) { o[0][r] = 0.f; o[1][r] = 0.f; }
    const int vlane = ((lane >> 4) & 1) * 32 + (lane & 3) * 8 + (4 * hi + ((lane & 15) >> 2)) * 64;
    for (int s = 0; s < ntile; ++s) {
        __syncthreads();
        if (s + 1 < ntile) ATT_LOAD_TILE(s + 1);
        const LAS unsigned char* Ks = lds + (s & 1) * 32768 + kvh * 8192;
        const LAS unsigned char* Vs = lds + (s & 1) * 32768 + 16384 + kvh * 8192;
        f32x16 p0v, p1v;
#pragma unroll
        for (int r = 0; r < 16; ++r) { p0v[r] = 0.f; p1v[r] = 0.f; }
        { const LAS unsigned char* kp = Ks + hi * 1024 + r32 * 16;
#pragma unroll
          for (int d0 = 0; d0 < 4; ++d0) { const bf16x8 k0 = *(const LAS bf16x8*)(kp + d0 * 2048), k1 = *(const LAS bf16x8*)(kp + d0 * 2048 + 512);
              p0v = __builtin_amdgcn_mfma_f32_32x32x16_bf16(k0, qr[d0], p0v, 0, 0, 0); p1v = __builtin_amdgcn_mfma_f32_32x32x16_bf16(k1, qr[d0], p1v, 0, 0, 0); } }
        if (s < nb) {
            const int kp0 = p0 - 128 + 64 * (tlo + s), qpos = p0 + r32;
#pragma unroll
            for (int r = 0; r < 16; ++r) { const int k0 = kp0 + crow(r, hi), k1 = k0 + 32;
                const bool v0 = (k0 >= 0) && (k0 < SEQ) && (k0 - qpos <= 128) && (qpos - k0 <= 128);
                const bool v1 = (k1 >= 0) && (k1 < SEQ) && (k1 - qpos <= 128) && (qpos - k1 <= 128);
                p0v[r] = v0 ? p0v[r] : -INFINITY; p1v[r] = v1 ? p1v[r] : -INFINITY; }
        }
        float tm = p0v[0];
#pragma unroll
        for (int r = 1; r < 16; ++r) tm = fmaxf(tm, p0v[r]);
#pragma unroll
        for (int r = 0; r < 16; ++r) tm = fmaxf(tm, p1v[r]);
        tm = swapmax(tm);
        const float mnew = fmaxf(mrun, tm);
        const float alpha = __builtin_amdgcn_exp2f(mrun - mnew);
        float ls = 0.f;
#pragma unroll
        for (int r = 0; r < 16; ++r) { p0v[r] = __builtin_amdgcn_exp2f(p0v[r] - mnew); p1v[r] = __builtin_amdgcn_exp2f(p1v[r] - mnew); ls += p0v[r] + p1v[r]; }
        lrun = lrun * alpha + ls; mrun = mnew;
#pragma unroll
        for (int r = 0; r < 16; ++r) { o[0][r] *= alpha; o[1][r] *= alpha; }
        v4u pw[4];
#pragma unroll
        for (int q = 0; q < 4; ++q) { pw[0][q] = cvt_pk_bf16(p0v[2 * q], p0v[2 * q + 1]); pw[1][q] = cvt_pk_bf16(p0v[8 + 2 * q], p0v[8 + 2 * q + 1]);
            pw[2][q] = cvt_pk_bf16(p1v[2 * q], p1v[2 * q + 1]); pw[3][q] = cvt_pk_bf16(p1v[8 + 2 * q], p1v[8 + 2 * q + 1]); }
#pragma unroll
        for (int dh = 0; dh < 2; ++dh)
#pragma unroll
            for (int ks = 0; ks < 4; ++ks) { const s16x4 lo = vtr(Vs + vlane + dh * 4096 + ks * 1024), hh = vtr(Vs + vlane + dh * 4096 + ks * 1024 + 512);
                const bf16x8 vf = (bf16x8){lo[0], lo[1], lo[2], lo[3], hh[0], hh[1], hh[2], hh[3]};
                o[dh] = __builtin_amdgcn_mfma_f32_32x32x16_bf16(vf, __builtin_bit_cast(bf16x8, pw[ks]), o[dh], 0, 0, 0); }
        if (s + 1 < ntile) ATT_WRITE_TILE((s + 1) & 1);
    }
    float lt = swapsum(lrun) + __builtin_amdgcn_exp2f(sink[hq] * LOG2E - mrun);
    const float inv = 1.0f / lt; float ssq = 0.f;
#pragma unroll
    for (int r = 0; r < 16; ++r) { o[0][r] *= inv; o[1][r] *= inv; ssq += o[0][r] * o[0][r] + o[1][r] * o[1][r]; }
    ssq = swapsum(ssq);
    if (hi == 0) xch[wid * 32 + r32] = ssq;
    __syncthreads();
    float tot = 0.f;
#pragma unroll
    for (int w = 0; w < 8; ++w) tot += xch[w * 32 + r32];
    const float rstd = 1.0f / sqrtf(tot * (1.0f / 512.0f) + EPS);
    bf16* orow = O + (size_t)(rowbase + p0 + r32) * DM + hq * 64;
#pragma unroll
    for (int dh = 0; dh < 2; ++dh)
#pragma unroll
        for (int rg = 0; rg < 4; ++rg) { const int d = 32 * dh + 8 * rg + 4 * hi; const f32x4 gg = *(const f32x4*)(g_attn + hq * 64 + d);
            v2u w; w.x = cvt_pk_bf16(o[dh][4 * rg] * rstd * gg[0], o[dh][4 * rg + 1] * rstd * gg[1]); w.y = cvt_pk_bf16(o[dh][4 * rg + 2] * rstd * gg[2], o[dh][4 * rg + 3] * rstd * gg[3]);
            *(v2u*)(orow + d) = w; }
    __syncthreads();
}

__device__ __forceinline__ void sgu_unit(Frame& F, int b, int ch) {
    const bf16* GV = (const bf16*)(F.ws + WS_GV); const bf16* U = (const bf16*)(F.ws + WS_U); const bf16* SW = (const bf16*)(F.ws + WS_SGUW); bf16* O = (bf16*)(F.ws + WS_O);
    const float* ln_g = F.in[13]; const float* ln_b = F.in[14]; const float* sgub = F.in[16]; const float* g_sgu = F.in[18];
    const int lane = F.lane, wid = F.wave, r0 = b * SEQ + ch * 128;
    LAS unsigned char* lds = F.lds; LAS float* xch = (LAS float*)(F.lds + L_XCH);
    { const int c0 = lane * 8; const f32x4 g0 = *(const f32x4*)(ln_g + c0), g1 = *(const f32x4*)(ln_g + c0 + 4), b0 = *(const f32x4*)(ln_b + c0), b1 = *(const f32x4*)(ln_b + c0 + 4);
      const int hh = lane >> 3, cc = (lane & 7) * 8;
      for (int jj = 0; jj < 16; ++jj) { const int j = wid * 16 + jj;
          const v4u raw = *(const v4u*)(GV + (size_t)(r0 + j) * 512 + c0);
          float x[8] = {bflo(raw.x), bfhi(raw.x), bflo(raw.y), bfhi(raw.y), bflo(raw.z), bfhi(raw.z), bflo(raw.w), bfhi(raw.w)};
          float s = 0.f;
#pragma unroll
          for (int q = 0; q < 8; ++q) s += x[q];
          const float mean = wave_sum(s) * (1.0f / 512.0f); float s2 = 0.f;
#pragma unroll
          for (int q = 0; q < 8; ++q) { x[q] -= mean; s2 += x[q] * x[q]; }
          const float rstd = 1.0f / sqrtf(wave_sum(s2) * (1.0f / 512.0f) + EPS);
          v4u o; o.x = cvt_pk_bf16(x[0] * rstd * g0[0] + b0[0], x[1] * rstd * g0[1] + b0[1]); o.y = cvt_pk_bf16(x[2] * rstd * g0[2] + b0[2], x[3] * rstd * g0[3] + b0[3]);
          o.z = cvt_pk_bf16(x[4] * rstd * g1[0] + b1[0], x[5] * rstd * g1[1] + b1[1]); o.w = cvt_pk_bf16(x[6] * rstd * g1[2] + b1[2], x[7] * rstd * g1[3] + b1[3]);
          *(LAS v4u*)(lds + hh * 16384 + ((j >> 3) * 2 + (cc >> 5)) * 512 + (j & 7) * 64 + (cc & 31) * 2) = o; } }
    __syncthreads();
    const int h = wid, kg = lane >> 4, il = lane & 15, q4 = il >> 2, p4 = il & 3;
    const LAS unsigned char* img = lds + h * 16384;
#pragma unroll 1
    for (int ip = 0; ip < 2; ++ip) {
        f32x4 acc[4][4];
#pragma unroll
        for (int cm = 0; cm < 4; ++cm)
#pragma unroll
            for (int in = 0; in < 4; ++in) acc[cm][in] = (f32x4){0.f, 0.f, 0.f, 0.f};
#pragma unroll 1
        for (int ks = 0; ks < 4; ++ks) {
            bf16x8 af[4], bfr[4];
#pragma unroll
            for (int cm = 0; cm < 4; ++cm) { const int off = ((4 * ks + kg) * 2 + (cm >> 1)) * 512 + q4 * 64 + (16 * (cm & 1) + 4 * p4) * 2;
                const s16x4 lo = vtr(img + off), hh2 = vtr(img + off + 256); af[cm] = (bf16x8){lo[0], lo[1], lo[2], lo[3], hh2[0], hh2[1], hh2[2], hh2[3]}; }
#pragma unroll
            for (int in = 0; in < 4; ++in) bfr[in] = *(const bf16x8*)(SW + (size_t)(h * 128 + 64 * ip + 16 * in + il) * 128 + 32 * ks + 8 * kg);
#pragma unroll
            for (int cm = 0; cm < 4; ++cm)
#pragma unroll
                for (int in = 0; in < 4; ++in) acc[cm][in] = __builtin_amdgcn_mfma_f32_16x16x32_bf16(af[cm], bfr[in], acc[cm][in], 0, 0, 0);
        }
#pragma unroll
        for (int in = 0; in < 4; ++in) { const int i = 64 * ip + 16 * in + il; const float bs = sgub[h * 128 + i]; float ss = 0.f;
#pragma unroll
            for (int cm = 0; cm < 4; ++cm) { const int c = h * 64 + 16 * cm + 4 * kg; const v2u ur = *(const v2u*)(U + (size_t)(r0 + i) * 512 + c);
                f32x4 v = acc[cm][in]; v[0] = (v[0] + bs) * bflo(ur.x); v[1] = (v[1] + bs) * bfhi(ur.x); v[2] = (v[2] + bs) * bflo(ur.y); v[3] = (v[3] + bs) * bfhi(ur.y);
                acc[cm][in] = v; ss += (v[0] * v[0] + v[1] * v[1]) + (v[2] * v[2] + v[3] * v[3]); }
            ss += __shfl_xor(ss, 16); ss += __shfl_xor(ss, 32);
            if (lane < 16) xch[h * 64 + 16 * in + il] = ss; }
        __syncthreads();
#pragma unroll
        for (int in = 0; in < 4; ++in) { const int i = 64 * ip + 16 * in + il; float tot = 0.f;
#pragma unroll
            for (int w = 0; w < 8; ++w) tot += xch[w * 64 + 16 * in + il];
            const float rstd = 1.0f / sqrtf(tot * (1.0f / 512.0f) + EPS);
#pragma unroll
            for (int cm = 0; cm < 4; ++cm) { const int c = h * 64 + 16 * cm + 4 * kg; const f32x4 gg = *(const f32x4*)(g_sgu + c); const f32x4 v = acc[cm][in];
                v2u w; w.x = cvt_pk_bf16(v[0] * rstd * gg[0], v[1] * rstd * gg[1]); w.y = cvt_pk_bf16(v[2] * rstd * gg[2], v[3] * rstd * gg[3]);
                *(v2u*)(O + (size_t)(r0 + i) * DM + 512 + c) = w; } }
        __syncthreads();
    }
}


__device__ __forceinline__ void naive_attn_token(Frame& F, int tok) {
    const bf16* Q = (const bf16*)(F.ws + WS_Q); const bf16* Kx = (const bf16*)(F.ws + WS_K); const bf16* Vx = (const bf16*)(F.ws + WS_V);
    const bf16* KC = (const bf16*)(F.ws + WS_KC); const bf16* VC = (const bf16*)(F.ws + WS_VC); bf16* O = (bf16*)(F.ws + WS_O);
    const int lane = F.lane, h = F.wave, kvh = h >> 2, b = tok >> 12, pos = tok & (SEQ - 1);
    LAS float* qs = (LAS float*)(F.lds) + h * 64; LAS float* sc = (LAS float*)(F.lds + 4096) + h * 768; LAS float* xs = (LAS float*)(F.lds + L_XCH);
    qs[lane] = bflo((unsigned)Q[(size_t)tok * 512 + h * 64 + lane]);
    __syncthreads();
    const int lo = pos - 128 < 0 ? 0 : pos - 128, hi = pos + 128 > SEQ - 1 ? SEQ - 1 : pos + 128, nband = hi - lo + 1, nk = nband + LC;
    float mx = F.in[12][h] * LOG2E;
    for (int base = 0; base < nk; base += 64) { const int idx = base + lane; float s = -INFINITY;
        if (idx < nk) { const bf16* kp = idx < nband ? Kx + (size_t)(b * SEQ + lo + idx) * 128 + kvh * 64 : KC + (size_t)(b * LC + idx - nband) * 128 + kvh * 64;
            s = 0.f; for (int d = 0; d < 64; ++d) s += qs[d] * bflo((unsigned)kp[d]); sc[idx] = s; }
        mx = fmaxf(mx, s); }
#pragma unroll
    for (int o2 = 1; o2 < 64; o2 <<= 1) mx = fmaxf(mx, __shfl_xor(mx, o2));
    __syncthreads();
    float l = 0.f, acc = 0.f;
    for (int idx = 0; idx < nk; ++idx) { const float p = __builtin_amdgcn_exp2f(sc[idx] - mx); l += p;
        const bf16* vp = idx < nband ? Vx + (size_t)(b * SEQ + lo + idx) * 128 + kvh * 64 : VC + (size_t)(b * LC + idx - nband) * 128 + kvh * 64;
        acc += p * bflo((unsigned)vp[lane]); }
    l += __builtin_amdgcn_exp2f(F.in[12][h] * LOG2E - mx);
    const float ov = acc / l; const float ss = wave_sum(ov * ov);
    if (lane == 0) xs[h] = ss;
    __syncthreads();
    float tot = 0.f;
    for (int w = 0; w < 8; ++w) tot += xs[w];
    const float rstd = 1.0f / sqrtf(tot * (1.0f / 512.0f) + EPS);
    O[(size_t)tok * DM + h * 64 + lane] = (bf16)f2bf(ov * rstd * F.in[17][h * 64 + lane]);
    __syncthreads();
}
__device__ __forceinline__ void naive_sgu_unit(Frame& F, int b, int ch) {
    const bf16* GV = (const bf16*)(F.ws + WS_GV); const bf16* U = (const bf16*)(F.ws + WS_U); bf16* O = (bf16*)(F.ws + WS_O);
    const float* ln_g = F.in[13]; const float* ln_b = F.in[14]; const float* sw = F.in[15]; const float* sgub = F.in[16]; const float* g_sgu = F.in[18];
    const int lane = F.lane, wid = F.wave, tid = F.tid, r0 = b * SEQ + ch * 128;
    LAS float* vl = (LAS float*)F.lds;
    LAS float* xs = (LAS float*)(F.lds + L_XCH);
    LAS float* st = xs + 16;
    for (int jj = 0; jj < 16; ++jj) { const int j = wid * 16 + jj; float x[8]; float s = 0.f;
#pragma unroll
        for (int q = 0; q < 8; ++q) { x[q] = bflo((unsigned)GV[(size_t)(r0 + j) * 512 + lane * 8 + q]); s += x[q]; }
        const float mean = wave_sum(s) * (1.0f / 512.0f); float s2 = 0.f;
#pragma unroll
        for (int q = 0; q < 8; ++q) { const float d = x[q] - mean; s2 += d * d; }
        const float rstd = 1.0f / sqrtf(wave_sum(s2) * (1.0f / 512.0f) + EPS);
        if (lane == 0) { st[2 * j] = mean; st[2 * j + 1] = rstd; } }
    __syncthreads();
    const int c = tid, h = c >> 6;
    for (int i = 0; i < 128; ++i) {
        float m = 0.f;
        for (int j = 0; j < 128; ++j) { const float gv = bflo((unsigned)GV[(size_t)(r0 + j) * 512 + c]); const float y = (gv - st[2 * j]) * st[2 * j + 1] * ln_g[c] + ln_b[c]; m += sw[(size_t)(h * 128 + i) * 128 + j] * y; }
        const float v = (m + sgub[h * 128 + i]) * bflo((unsigned)U[(size_t)(r0 + i) * 512 + c]);
        const float ss = wave_sum(v * v);
        __syncthreads();
        if (lane == 0) xs[wid] = ss;
        __syncthreads();
        float tot = 0.f;
        for (int w = 0; w < 8; ++w) tot += xs[w];
        const float rstd = 1.0f / sqrtf(tot * (1.0f / 512.0f) + EPS);
        O[(size_t)(r0 + i) * DM + 512 + c] = (bf16)f2bf(v * rstd * g_sgu[c]);
    }
    __syncthreads();
}


constexpr int CW_FLAGS = 32768;
__device__ __forceinline__ double dcos_red(double a) { const double tp = 6.283185307179586; a -= tp * floor(a / tp + 0.5); double t = 1.0, s = 1.0; for (int i = 1; i < 16; ++i) { t *= -a * a / ((2.0 * i - 1.0) * (2.0 * i)); s += t; } return s; }
__device__ __forceinline__ double dsin_red(double a) { const double tp = 6.283185307179586; a -= tp * floor(a / tp + 0.5); double t = a, s = a; for (int i = 1; i < 16; ++i) { t *= -a * a / ((2.0 * i) * (2.0 * i + 1.0)); s += t; } return s; }
__device__ __forceinline__ bool close_to(float got, float want, float atol, float rtol) { return fabsf(got - want) <= atol + rtol * fabsf(want); }
__device__ __forceinline__ void debug_checks(Frame& F) {
    const float* MOD = (const float*)(F.ws + WS_MOD); const bf16* H = (const bf16*)(F.ws + WS_H);
    const bf16* Q = (const bf16*)(F.ws + WS_Q); const bf16* Kx = (const bf16*)(F.ws + WS_K); const bf16* Vx = (const bf16*)(F.ws + WS_V);
    const bf16* KC = (const bf16*)(F.ws + WS_KC); const bf16* VC = (const bf16*)(F.ws + WS_VC); const bf16* U = (const bf16*)(F.ws + WS_U); const bf16* GV = (const bf16*)(F.ws + WS_GV);
    const bf16* O = (const bf16*)(F.ws + WS_O); const bf16* MIX = (const bf16*)(F.ws + WS_MIX);
    const int gw = blockIdx.x * NWAVES + F.wave, lane = F.lane;
    unsigned bad = 0u;
    for (int q = 0; q < 4; ++q) { const unsigned hsh = (unsigned)(gw * 4 + q) * 2654435761u; const int r = (hsh >> 8) % 9, n = (hsh >> 12) % NMOD;
        float a = 0.f; for (int k = lane; k < DM; k += 64) { const float v = r < 8 ? F.in[1][r * DM + k] : F.in[3][k]; a += v / (1.0f + expf(-v)) * F.in[4][(size_t)k * NMOD + n]; }
        a = wave_sum(a) + F.in[5][n];
        if (!close_to(MOD[r * NMOD + n], a, 1e-3f, 1e-3f)) bad |= 1u; }
    for (int q = 0; q < 2; ++q) { const unsigned hsh = (unsigned)(gw * 2 + q) * 2246822519u; const int m = (hsh >> 7) % (TT + TC);
        const float* xrow = m < TT ? F.in[0] + (size_t)m * DM : F.in[2] + (size_t)(m - TT) * DM; const float* md = MOD + (m < TT ? (m >> 12) : 8) * NMOD;
        float ss = 0.f; for (int k = lane; k < DM; k += 64) ss += xrow[k] * xrow[k];
        const float rstd = 1.0f / sqrtf(wave_sum(ss) / DM + EPS);
        for (int k = lane; k < DM; k += 64) { const float want = xrow[k] * rstd * F.in[6][k] * (1.0f + md[DM + k]) + md[k];
            if (!close_to(bflo((unsigned)H[(size_t)m * DM + k]), want, 2e-2f, 1e-2f)) bad |= 2u; } }
    for (int q = 0; q < 8; ++q) { const unsigned hsh = (unsigned)(gw * 8 + q) * 3266489917u; const int kind = q;
        const int row = kind == 7 ? TT + (int)((hsh >> 6) % TC) : (int)((hsh >> 6) % TT); const int d = (hsh >> 3) & 15;
        int n1, n2;
        if (kind < 2) { const int hd = (hsh >> 20) & 7; n1 = hd * 64 + (kind & 1) * 32 + d; n2 = n1 + 16; }
        else if (kind < 4) { const int hd = (hsh >> 20) & 1; n1 = 512 + hd * 64 + (kind & 1) * 32 + d; n2 = n1 + 16; }
        else if (kind == 4) { n1 = 640 + ((hsh >> 20) & 127); n2 = n1; }
        else if (kind == 5) { n1 = 768 + ((hsh >> 20) & 511); n2 = n1; }
        else if (kind == 6) { n1 = 1280 + ((hsh >> 20) & 511); n2 = n1; }
        else { n1 = 512 + ((hsh >> 20) & 127); n2 = n1 + 128; }
        float a1 = 0.f, a2 = 0.f;
        for (int k = lane; k < DM; k += 64) { const float hv = bflo((unsigned)H[(size_t)row * DM + k]); a1 += hv * F.in[10][(size_t)k * NIN + n1]; a2 += hv * F.in[10][(size_t)k * NIN + n2]; }
        a1 = wave_sum(a1) + F.in[11][n1]; a2 = wave_sum(a2) + F.in[11][n2];
        if (kind < 4) { const int t = row & (SEQ - 1); const int pos = (kind & 1) ? (t & 63) : (t >> 6);
            const double ang = (double)pos * pow(10000.0, -(double)d / 16.0); const float cs = (float)dcos_red(ang), sn = (float)dsin_red(ang);
            float w1 = a1 * cs - a2 * sn, w2 = a2 * cs + a1 * sn; if (kind < 2) { w1 *= QSCALE; w2 *= QSCALE; }
            const float g1 = kind < 2 ? bflo((unsigned)Q[(size_t)row * 512 + n1]) : bflo((unsigned)Kx[(size_t)row * 128 + n1 - 512]);
            const float g2 = kind < 2 ? bflo((unsigned)Q[(size_t)row * 512 + n2]) : bflo((unsigned)Kx[(size_t)row * 128 + n2 - 512]);
            if (!close_to(g1, w1, 3e-2f, 3e-2f) || !close_to(g2, w2, 3e-2f, 3e-2f)) bad |= (kind < 2 ? 4u : 8u); }
        else if (kind == 4) { if (!close_to(bflo((unsigned)Vx[(size_t)row * 128 + n1 - 640]), a1, 3e-2f, 3e-2f)) bad |= 16u; }
        else if (kind == 5 || kind == 6) { const float u0 = 0.7978845608f * (a1 + 0.044715f * a1 * a1 * a1); const float want = 0.5f * a1 * (1.0f + tanhf(u0));
            const float got = kind == 5 ? bflo((unsigned)U[(size_t)row * 512 + n1 - 768]) : bflo((unsigned)GV[(size_t)row * 512 + n1 - 1280]);
            if (!close_to(got, want, 3e-2f, 3e-2f)) bad |= 32u; }
        else { const float g1 = bflo((unsigned)KC[(size_t)(row - TT) * 128 + n1 - 512]), g2 = bflo((unsigned)VC[(size_t)(row - TT) * 128 + n1 - 512]);
            if (!close_to(g1, a1, 3e-2f, 3e-2f) || !close_to(g2, a2, 3e-2f, 3e-2f)) bad |= 64u; }
    }
    for (int q = 0; q < 2; ++q) { const unsigned hsh = (unsigned)(gw * 2 + q) * 668265263u; const int row = (hsh >> 6) % TT, n = (hsh >> 22) & 1023;
        float a = 0.f; for (int k = lane; k < DM; k += 64) a += bflo((unsigned)O[(size_t)row * DM + k]) * F.in[19][(size_t)k * DM + n];
        a = wave_sum(a) + F.in[20][n];
        if (!close_to(bflo((unsigned)MIX[(size_t)row * DM + n]), a, 5e-2f, 3e-2f)) bad |= 128u; }
    if (bad && lane == 0) atomicOr((unsigned*)(F.ctl + CW_FLAGS), bad);
}

__device__ __forceinline__ void p5_rows(Frame& F) {
    const float* MOD = (const float*)(F.ws + WS_MOD); const bf16* MIX = (const bf16*)(F.ws + WS_MIX); unsigned char* H2 = F.ws + WS_H2;
    float* GATES = (float*)(F.ws + WS_GATES); int* ROWDST = (int*)(F.ws + WS_ROWDST);
    const float* g_post = F.in[7]; const float* g_pre = F.in[8]; const float* w_router = F.in[21]; const float* b_router = F.in[22];
    const int lane = F.lane, wid = F.wave, tid = F.tid;
    LAS float* wl = (LAS float*)F.lds;
    LAS int* lcount = (LAS int*)(F.lds + L_SEL); LAS int* lbase = lcount + 32; LAS int* sel_e = lcount + 64; LAS int* sel_slot = lcount + 64 + 512;
    for (int q = tid; q < 8192; q += NWAVES * 64) { const int k = q >> 3, ec = q & 7; const f32x4 v = *(const f32x4*)(w_router + k * 32 + 4 * ec);
        const int l = (k & 255) >> 2, j = k >> 8, i4 = k & 3; *(LAS f32x4*)(wl + (((j * 4 + i4) * 8 + ec) * 64 + l) * 4) = v; }
    if (tid < 32) lcount[tid] = 0;
    __syncthreads();
    for (int chunk = blockIdx.x; chunk < TT / 128; chunk += F.G) {
        f32x4 a1[4], a2[4], a3[4];
        { const float* md = MOD + ((chunk * 128) >> 12) * NMOD;
#pragma unroll
          for (int j = 0; j < 4; ++j) { const int col = 4 * lane + 256 * j;
              a1[j] = *(const f32x4*)(g_post + col) * *(const f32x4*)(md + 2 * DM + col);
              a2[j] = *(const f32x4*)(g_pre + col) * (*(const f32x4*)(md + 4 * DM + col) + 1.0f);
              a3[j] = *(const f32x4*)(md + 3 * DM + col); } }
        f32x4 xn[4]; v2u mn[4];
        { const int tok0 = chunk * 128 + wid * 16; const GAS f32x4* xr = (const GAS f32x4*)(F.in[0] + (size_t)tok0 * DM) + lane; const GAS v2u* mr = (const GAS v2u*)(MIX + (size_t)tok0 * DM) + lane;
#pragma unroll
          for (int j = 0; j < 4; ++j) { xn[j] = xr[64 * j]; mn[j] = mr[64 * j]; } }
#pragma unroll 1
        for (int tt = 0; tt < 16; ++tt) {
            const int tokl = wid * 16 + tt, tok = chunk * 128 + tokl;
            f32x4 xv[4], mv[4]; float s = 0.f;
#pragma unroll
            for (int j = 0; j < 4; ++j) { xv[j] = xn[j]; const v2u m2 = mn[j]; mv[j] = (f32x4){bflo(m2.x), bfhi(m2.x), bflo(m2.y), bfhi(m2.y)};
                s += (mv[j].x * mv[j].x + mv[j].y * mv[j].y) + (mv[j].z * mv[j].z + mv[j].w * mv[j].w); }
            if (tt + 1 < 16) {
                const GAS f32x4* xr = (const GAS f32x4*)(F.in[0] + (size_t)(tok + 1) * DM) + lane; const GAS v2u* mr = (const GAS v2u*)(MIX + (size_t)(tok + 1) * DM) + lane;
#pragma unroll
                for (int j = 0; j < 4; ++j) { xn[j] = xr[64 * j]; mn[j] = mr[64 * j]; } }
            const float rstd1 = 1.0f / sqrtf(wave_sum(s) * (1.0f / DM) + EPS);
            float s2 = 0.f;
            GAS f32x4* xo = (GAS f32x4*)(F.out + (size_t)tok * DM) + lane;
#pragma unroll
            for (int j = 0; j < 4; ++j) { xv[j] = xv[j] + a1[j] * (mv[j] * rstd1); xo[64 * j] = xv[j];
                s2 += (xv[j].x * xv[j].x + xv[j].y * xv[j].y) + (xv[j].z * xv[j].z + xv[j].w * xv[j].w); }
            const float rstd2 = 1.0f / sqrtf(wave_sum(s2) * (1.0f / DM) + EPS);
            GAS unsigned* ho = (GAS unsigned*)(H2 + (size_t)tok * DM) + lane;
#pragma unroll
            for (int j = 0; j < 4; ++j) { xv[j] = xv[j] * rstd2 * a2[j] + a3[j]; ho[64 * j] = pk4_fp8(xv[j].x * H2_SCALE, xv[j].y * H2_SCALE, xv[j].z * H2_SCALE, xv[j].w * H2_SCALE); }
            float a[32];
#pragma unroll
            for (int e = 0; e < 32; ++e) a[e] = 0.f;
#pragma unroll
            for (int j = 0; j < 4; ++j)
#pragma unroll
                for (int i4 = 0; i4 < 4; ++i4) { const float hv = xv[j][i4];
#pragma unroll
                    for (int ec = 0; ec < 8; ++ec) { const f32x4 w4 = *(const LAS f32x4*)(wl + (((j * 4 + i4) * 8 + ec) * 64 + lane) * 4);
                        a[4 * ec] += hv * w4[0]; a[4 * ec + 1] += hv * w4[1]; a[4 * ec + 2] += hv * w4[2]; a[4 * ec + 3] += hv * w4[3]; } }
#pragma unroll
            for (int i = 0; i < 16; ++i) { const bool up = (lane & 32) != 0; const float send = up ? a[i] : a[i + 16], keep = up ? a[i + 16] : a[i]; a[i] = keep + __shfl_xor(send, 32); }
#pragma unroll
            for (int i = 0; i < 8; ++i) { const bool up = (lane & 16) != 0; const float send = up ? a[i] : a[i + 8], keep = up ? a[i + 8] : a[i]; a[i] = keep + __shfl_xor(send, 16); }
#pragma unroll
            for (int i = 0; i < 4; ++i) { const bool up = (lane & 8) != 0; const float send = up ? a[i] : a[i + 4], keep = up ? a[i + 4] : a[i]; a[i] = keep + __shfl_xor(send, 8); }
#pragma unroll
            for (int i = 0; i < 2; ++i) { const bool up = (lane & 4) != 0; const float send = up ? a[i] : a[i + 2], keep = up ? a[i + 2] : a[i]; a[i] = keep + __shfl_xor(send, 4); }
            { const bool up = (lane & 2) != 0; const float send = up ? a[0] : a[1], keep = up ? a[1] : a[0]; a[0] = keep + __shfl_xor(send, 2); }
            float lg = a[0] + __shfl_xor(a[0], 1);
            lg += b_router[lane >> 1];
            int esel[4]; float vsel[4];
#pragma unroll
            for (int k = 0; k < 4; ++k) { float m = lg;
#pragma unroll
                for (int o2 = 2; o2 < 64; o2 <<= 1) m = fmaxf(m, __shfl_xor(m, o2));
                const unsigned long long mask = __ballot(lg == m); const int first = __ffsll((long long)mask) - 1;
                esel[k] = first >> 1; vsel[k] = m; if ((lane >> 1) == esel[k]) lg = -INFINITY; }
            float wk[4], wsum = 0.f;
#pragma unroll
            for (int k = 0; k < 4; ++k) { wk[k] = __expf(vsel[k] - vsel[0]); wsum += wk[k]; }
            if (lane < 4) { const float gk = (lane == 0 ? wk[0] : lane == 1 ? wk[1] : lane == 2 ? wk[2] : wk[3]) / wsum; const int ek = lane == 0 ? esel[0] : lane == 1 ? esel[1] : lane == 2 ? esel[2] : esel[3];
                GATES[(size_t)tok * 4 + lane] = gk;
                const int slot = __hip_atomic_fetch_add(lcount + ek, 1, __ATOMIC_RELAXED, __HIP_MEMORY_SCOPE_WORKGROUP);
                sel_e[tokl * 4 + lane] = ek; sel_slot[tokl * 4 + lane] = slot; }
        }
        __syncthreads();
        if (tid < 32) lbase[tid] = (int)__hip_atomic_fetch_add((unsigned*)(F.ctl + CW_CNT + 64 * tid), (unsigned)lcount[tid], RLX_AGENT);
        __syncthreads();
        { const int e = sel_e[tid]; ROWDST[(size_t)e * ECAP + lbase[e] + sel_slot[tid]] = (chunk * 128 + (tid >> 2)) * 4 + (tid & 3); }
        __syncthreads();
        if (tid < 32) lcount[tid] = 0;
        __syncthreads();
    }
}

__device__ __forceinline__ void moe_tables(Frame& F) {
    LAS unsigned char* tile_e = F.lds + L_TILEE; LAS int* tab = (LAS int*)(F.lds + L_CNT);
    __syncthreads();
    if (F.tid < 32) tab[F.tid] = (int)__hip_atomic_load((unsigned*)(F.ctl + CW_CNT + 64 * F.tid), RLX_AGENT);
    __syncthreads();
    if (F.tid == 0) { int acc = 0; for (int e = 0; e < 32; ++e) { tab[32 + e] = acc; acc += (tab[e] + 255) >> 8; } tab[64] = acc; tab[65] = acc < MAXTILES ? acc : MAXTILES; }
    __syncthreads();
    for (int e = F.wave; e < 32; e += NWAVES) { const int f = tab[32 + e], n = (tab[e] + 255) >> 8; for (int q = F.lane; q < n; q += 64) if (f + q < MAXTILES) tile_e[f + q] = (unsigned char)e; }
    __syncthreads();
}

__device__ __forceinline__ void p8_final(Frame& F) {
    const float* MOD = (const float*)(F.ws + WS_MOD); const bf16* Y4 = (const bf16*)(F.ws + WS_Y4); const float* GATES = (const float*)(F.ws + WS_GATES); const float* g_post = F.in[9];
    const int gw = F.vcu * NWAVES + F.wave, NGW = F.G * NWAVES, lane = F.lane;
    constexpr int TPW = 16;
    for (int t0 = gw * TPW; t0 < TT; t0 += NGW * TPW) {
        f32x4 a1[4];
        { const float* md = MOD + (t0 >> 12) * NMOD + 5 * DM;
#pragma unroll
          for (int j = 0; j < 4; ++j) { const int col = 4 * lane + 256 * j; a1[j] = *(const f32x4*)(g_post + col) * *(const f32x4*)(md + col); } }
        v2u yn[4][4]; f32x4 xn[4]; f32x4 gn;
#define P8_LOAD(tok_) do { gn = *(const f32x4*)(GATES + (size_t)(tok_) * 4); \
            _Pragma("unroll") for (int k = 0; k < 4; ++k) { const GAS v2u* yr = (const GAS v2u*)(Y4 + ((size_t)(tok_) * 4 + k) * DM) + lane; _Pragma("unroll") for (int j = 0; j < 4; ++j) yn[k][j] = yr[64 * j]; } \
            { const GAS f32x4* xr = (const GAS f32x4*)(F.out + (size_t)(tok_) * DM) + lane; _Pragma("unroll") for (int j = 0; j < 4; ++j) xn[j] = xr[64 * j]; } } while (0)
        P8_LOAD(t0);
#pragma unroll 1
        for (int tt = 0; tt < TPW; ++tt) {
            const int tok = t0 + tt;
            f32x4 y[4], xm[4]; float s = 0.f;
#pragma unroll
            for (int j = 0; j < 4; ++j) { y[j] = (f32x4){0.f, 0.f, 0.f, 0.f}; xm[j] = xn[j]; }
#pragma unroll
            for (int k = 0; k < 4; ++k) { const float gk = gn[k];
#pragma unroll
                for (int j = 0; j < 4; ++j) { const v2u m2 = yn[k][j]; y[j] = y[j] + (f32x4){bflo(m2.x), bfhi(m2.x), bflo(m2.y), bfhi(m2.y)} * gk; } }
            if (tt + 1 < TPW) P8_LOAD(tok + 1);
#pragma unroll
            for (int j = 0; j < 4; ++j) s += (y[j].x * y[j].x + y[j].y * y[j].y) + (y[j].z * y[j].z + y[j].w * y[j].w);
            const float rstd = 1.0f / sqrtf(wave_sum(s) * (1.0f / DM) + EPS);
            GAS f32x4* xo = (GAS f32x4*)(F.out + (size_t)tok * DM) + lane;
#pragma unroll
            for (int j = 0; j < 4; ++j) {
                if (PROBE == 1) xo[64 * j] = xm[j];
                else if (PROBE == 2) xo[64 * j] = *((const GAS f32x4*)(F.in[0] + (size_t)tok * DM) + lane + 64 * j);
                else xo[64 * j] = xm[j] + a1[j] * (y[j] * rstd); }
        }
#undef P8_LOAD
    }
}

constexpr int N_LAUNCHES = MK_N_LAUNCHES;
constexpr int PER_PHASE = 9;
struct Args { const float* in[27]; float* out; unsigned char* ws; int ph_lo, ph_hi; };
__global__ void __launch_bounds__(NWAVES * 64, 2) fwd_kernel(Args args) {
    extern __shared__ __attribute__((aligned(16))) unsigned char lds_raw[];
    Frame F;
    F.lds = (LAS unsigned char*)lds_raw;
    F.tid = threadIdx.x; F.lane = F.tid & 63; F.wave = __builtin_amdgcn_readfirstlane(F.tid >> 6);
    F.G = gridDim.x; { const int bx = blockIdx.x; F.vcu = (F.G % 8 == 0) ? (bx % 8) * (F.G / 8) + bx / 8 : bx; }
#pragma unroll
    for (int i = 0; i < 27; ++i) F.in[i] = args.in[i];
    F.out = args.out; F.ws = args.ws; F.ctl = (gu32*)(args.ws + WS_CTL);
    for (int u = F.tid; u < (LDS_BYTES - MISC_OFF) / 4; u += NWAVES * 64) ((LAS unsigned*)(F.lds + MISC_OFF))[u] = 0u;
    __syncthreads();
    XcdBarrier bar; bar.bar = (unsigned*)(F.ctl + CW_BAR); bar.x = 0; bar.st = nullptr;
    if (N_LAUNCHES != PER_PHASE) bar = xcd_barrier_post((unsigned*)(F.ctl + CW_BAR), (volatile LAS unsigned*)(F.lds + L_BARW));
#define GRID_BAR() do { if (N_LAUNCHES == PER_PHASE) { if (F.tid == 0) __hip_atomic_store(F.ctl + CW_TMO, 0xBADBA0u, RLX_AGENT); } else { xcd_barrier(bar); } } while (0)
    const int lo = args.ph_lo, hi = args.ph_hi;
#define IN(k) (lo <= (k) && (k) < hi)
#define BOTH(k) (IN(k) && IN((k) + 1))

#define REFRESH() do { int t_ = threadIdx.x; asm volatile("" : "+v"(t_)); F.tid = t_; F.lane = t_ & 63; F.wave = __builtin_amdgcn_readfirstlane(t_ >> 6); \
        const __attribute__((address_space(4))) Args* ap_ = (const __attribute__((address_space(4))) Args*)__builtin_amdgcn_kernarg_segment_ptr(); asm volatile("" : "+s"(ap_)); \
        _Pragma("unroll") for (int i_ = 0; i_ < 27; ++i_) F.in[i_] = ap_->in[i_]; F.out = ap_->out; F.ws = ap_->ws; F.ctl = (gu32*)(ap_->ws + WS_CTL); } while (0)
#define REP(k) _Pragma("unroll") for (int rep_ = 0; rep_ < (DUP_PHASE == (k) ? 2 : 1); ++rep_)
    if (IN(0)) { REFRESH(); REP(0) { p0_prologue(F); if (BOTH(0)) GRID_BAR(); } }
    if (IN(1)) { REFRESH(); REP(1) { p1_prenorm(F); if (BOTH(1)) GRID_BAR(); } }
    if (IN(2)) { REFRESH(); REP(2) {
        pg8::SchedIn S{F.G, (int)blockIdx.x};
        pg8::EpiInProj E{F.in[11], (bf16*)(F.ws + WS_Q), (bf16*)(F.ws + WS_K), (bf16*)(F.ws + WS_V), (bf16*)(F.ws + WS_KC), (bf16*)(F.ws + WS_VC), (bf16*)(F.ws + WS_U), (bf16*)(F.ws + WS_GV), (const float*)(F.ws + WS_ROPE)};
        pg8::gemm_phase<pg8::EpiInProj, pg8::SchedIn, 0, true>(F.lds, (const bf16*)(F.ws + WS_H), (const bf16*)(F.ws + WS_WIN), DM, S, E);
        if (BOTH(2)) GRID_BAR();
    } }
    if (IN(3)) { REFRESH(); REP(3) {
#if NAIVE_ATTN
        for (int t = blockIdx.x; t < TT; t += F.G) naive_attn_token(F, t);
#else
        for (int u = F.vcu; u < NB * 128; u += F.G) attn_unit(F, u >> 7, u & 127);
#endif
#if NAIVE_SGU
        for (int u = F.vcu; u < NB * 32; u += F.G) naive_sgu_unit(F, u >> 5, u & 31);
#else
        for (int u = F.vcu; u < NB * 32; u += F.G) sgu_unit(F, u >> 5, u & 31);
#endif
        if (BOTH(3)) GRID_BAR();
    } }
    if (IN(4)) { REFRESH(); REP(4) {
        pg8::SchedOut S{F.G, (int)blockIdx.x};
        pg8::EpiOut E{F.in[20], (bf16*)(F.ws + WS_MIX)};
        pg8::gemm_phase<pg8::EpiOut, pg8::SchedOut, 0, true>(F.lds, (const bf16*)(F.ws + WS_O), (const bf16*)(F.ws + WS_WOUT), DM, S, E);
        if (BOTH(4)) GRID_BAR();
    } }
#if CHECKS
    if (IN(5)) { debug_checks(F); __syncthreads(); }
#endif
    if (IN(5)) { REFRESH(); p5_rows(F); if (BOTH(5)) GRID_BAR(); }
    if (IN(6)) { REFRESH(); REP(6) {
        moe_tables(F);
        pg8::SchedMoe<8, 1> S{F.G, (int)blockIdx.x, F.lds + L_TILEE, (const LAS int*)(F.lds + L_CNT), (const int*)(F.ws + WS_ROWDST)};
        pg8::EpiSwiglu E{F.in[24], F.ws + WS_ACT};
        pg8::gemm_phase<pg8::EpiSwiglu, pg8::SchedMoe<8, 1>, 1, true, true>(F.lds, F.ws + WS_H2, F.ws + WS_WGU, DM, S, E);
        if (BOTH(6)) GRID_BAR();
    } }
    if (IN(7)) { REFRESH(); REP(7) {
        moe_tables(F);
        pg8::SchedMoe<4, 1> S{F.G, (int)blockIdx.x, F.lds + L_TILEE, (const LAS int*)(F.lds + L_CNT), (const int*)(F.ws + WS_ROWDST)};
        pg8::EpiDown E{F.in[26], (bf16*)(F.ws + WS_Y4)};
        pg8::gemm_phase<pg8::EpiDown, pg8::SchedMoe<4, 1>, 2, true, true>(F.lds, F.ws + WS_ACT, F.ws + WS_WD, FF, S, E);
        if (BOTH(7)) GRID_BAR();
    } }
    if (IN(8)) { REFRESH(); p8_final(F); }
#undef IN
#undef BOTH
}

extern "C" void kernel_launch(void* const* d_in, const int* in_sizes, int n_in, void* d_out, int out_size, void* d_ws, size_t ws_size, hipStream_t stream) {
    static int grid = 0;
    if (grid == 0) {
        if (n_in != 27 || in_sizes[0] != TT * DM || out_size != TT * DM || ws_size < WS_END) { fprintf(stderr, "kernel_launch: unexpected problem (n_in %d, in0 %d, out %d, ws %zu); nothing launched\n", n_in, n_in > 0 ? in_sizes[0] : -1, out_size, ws_size); grid = -1; return; }
        int dev = 0, cus = 0, per_cu = 0;
        if (hipGetDevice(&dev) != hipSuccess || hipDeviceGetAttribute(&cus, hipDeviceAttributeMultiprocessorCount, dev) != hipSuccess) { grid = -1; return; }
        if (hipFuncSetAttribute((const void*)fwd_kernel, hipFuncAttributeMaxDynamicSharedMemorySize, LDS_BYTES) != hipSuccess) { fprintf(stderr, "kernel_launch: hipFuncSetAttribute failed\n"); grid = -1; return; }
        if (hipOccupancyMaxActiveBlocksPerMultiprocessor(&per_cu, (const void*)fwd_kernel, NWAVES * 64, LDS_BYTES) != hipSuccess || per_cu < 1)
            fprintf(stderr, "kernel_launch: note: occupancy query reports %d workgroups per CU\n", per_cu);
        (void)hipGetLastError();
        grid = cus;
    }
    if (grid < 0) return;
    if (hipMemsetAsync((char*)d_ws + WS_CTL, 0, CTL_ZERO_BYTES, stream) != hipSuccess) { fprintf(stderr, "kernel_launch: memset failed\n"); return; }
    Args a{};
    for (int i = 0; i < 27; ++i) a.in[i] = (const float*)d_in[i];
    a.out = (float*)d_out; a.ws = (unsigned char*)d_ws;
    for (int li = 0; li < N_LAUNCHES; ++li) {
        if (N_LAUNCHES == PER_PHASE) { a.ph_lo = li; a.ph_hi = li + 1; } else { a.ph_lo = 0; a.ph_hi = PER_PHASE; }
        hipLaunchKernelGGL(fwd_kernel, dim3(grid), dim3(NWAVES * 64), LDS_BYTES, stream, a);
        const hipError_t le = hipPeekAtLastError();
        if (le != hipSuccess) { fprintf(stderr, "kernel_launch: launch %d failed: %s\n", li, hipGetErrorName(le)); break; }
    }
}
```
